# Optimizing an MI355X kernel written in HIP

```python
import jax, jax.numpy as jnp
from jax import lax
import numpy as np

D_MODEL = 1024
BATCH = 16
SEQ = 2048
DEPTH = 4

GRID_W = 64
CTX_LEN = 256
HEAD_DIM = 64
D_RWKV = D_MODEL // 2
D_NA = D_MODEL - D_RWKV
H_RWKV = D_RWKV // HEAD_DIM
H_NA = D_NA // HEAD_DIM
NA_ROWS_MAX = 8
NA_COLS = 16
R_DECAY = 64
R_AAA = 64
R_GATE = 128
D_SHIFT = 3 * D_RWKV + 2 * R_DECAY + 2 * R_AAA + R_GATE
D_IN = 3 * D_NA + D_SHIFT
D_FF = 2816
N_EXPERTS = 8
TOP_K = 2
D_FF_EXPERT = 3584
MOE_BLOCK = 256
RMS_EPS = 1e-6
GN_EPS = 64e-5
L2_EPS = 1e-12

kernel_name = "hybrid_rwkv7_natten_moe_dit"


def _rms_norm(x, g):
    xf = x.astype(jnp.float32)
    y = xf * lax.rsqrt(jnp.mean(xf * xf, axis=-1, keepdims=True) + RMS_EPS)
    return (y * g.astype(jnp.float32)).astype(x.dtype)


def _centred_shift(p, mu):
    z = jnp.zeros_like(p[:, :1])
    prev = jnp.concatenate([z, p[:, :-1]], axis=1)
    nxt = jnp.concatenate([p[:, 1:], z], axis=1)
    return p + mu * (0.5 * (prev + nxt) - p)


def _rwkv_features(u, w0, w2, a0, a2, g2, k_k, k_a):
    B, T, _ = u.shape
    C = D_RWKV
    r = u[..., :C]
    k = u[..., C:2 * C]
    v = u[..., 2 * C:3 * C]
    o = 3 * C
    wl = u[..., o:o + 2 * R_DECAY].reshape(B, T, 2, R_DECAY)
    o += 2 * R_DECAY
    al = u[..., o:o + 2 * R_AAA].reshape(B, T, 2, R_AAA)
    o += 2 * R_AAA
    gl = u[..., o:o + R_GATE]
    w_log = -jax.nn.softplus(-(w0 + jnp.einsum('btzr,zrc->btzc', jnp.tanh(wl), w2))) - 0.5
    decay = jnp.exp(-jnp.exp(w_log.astype(jnp.float32)))
    a = jax.nn.sigmoid(a0 + jnp.einsum('btzr,zrc->btzc', al, a2))
    g = jax.nn.sigmoid(gl) @ g2
    kk = (k * k_k).reshape(B, T, H_RWKV, HEAD_DIM).astype(jnp.float32)
    kk = kk / jnp.maximum(jnp.sqrt(jnp.sum(kk * kk, axis=-1, keepdims=True)), L2_EPS)
    k_dir = k[:, :, None, :] * (1.0 + (a - 1.0) * k_a)
    return r, k_dir, v, kk, decay, a, g


def _rwkv_scan(feats, d, s0, reverse):
    r, k_dir, v, kk, decay, a, g = feats
    B, T, _ = r.shape

    def hs(t):
        return t.reshape(B, T, H_RWKV, HEAD_DIM).astype(jnp.float32)

    seqs = (hs(r), hs(decay[:, :, d]), hs(k_dir[:, :, d]), hs(v), kk, kk * hs(a[:, :, d]))
    xs = tuple(jnp.moveaxis(t, 1, 0) for t in seqs)

    def step(s, inp):
        r_t, w_t, k_t, v_t, kk_t, b_t = inp
        sa = jnp.einsum('bhvk,bhk->bhv', s, kk_t)
        s = s * w_t[:, :, None, :] - sa[..., None] * b_t[:, :, None, :] + v_t[..., None] * k_t[:, :, None, :]
        return s, jnp.einsum('bhvk,bhk->bhv', s, r_t)

    s_fin, ys = lax.scan(step, s0, xs, reverse=reverse)
    return jnp.moveaxis(ys, 0, 1), s_fin


def _rwkv_readout(y, feats, r_k, ln_w, ln_b):
    r, k_dir, v, kk, decay, a, g = feats
    B, T, _ = r.shape
    mu = jnp.mean(y, axis=-1, keepdims=True)
    var = jnp.mean(jnp.square(y - mu), axis=-1, keepdims=True)
    yn = ((y - mu) * lax.rsqrt(var + GN_EPS)).reshape(B, T, D_RWKV) * ln_w + ln_b
    rh = r.reshape(B, T, H_RWKV, HEAD_DIM)
    kh = jnp.mean(k_dir, axis=2).reshape(B, T, H_RWKV, HEAD_DIM)
    vh = v.reshape(B, T, H_RWKV, HEAD_DIM)
    bonus = (jnp.sum(rh * kh * r_k, axis=-1, keepdims=True) * vh).reshape(B, T, D_RWKV)
    return (yn.astype(r.dtype) + bonus) * g


def _rwkv_group(u_lat, u_ctx, w0, w2, a0, a2, g2, k_k, k_a, r_k, ln_w, ln_b, need_ctx_out):
    f_lat = _rwkv_features(u_lat, w0, w2, a0, a2, g2, k_k, k_a)
    f_ctx = _rwkv_features(u_ctx, w0, w2, a0, a2, g2, k_k, k_a)
    B = u_lat.shape[0]
    ys_lat, ys_ctx = [], []
    for d, rev in enumerate((False, True)):
        s0 = jnp.zeros((B, H_RWKV, HEAD_DIM, HEAD_DIM), jnp.float32)
        y_c, s_c = _rwkv_scan(f_ctx, d, s0, rev)
        y_l, _ = _rwkv_scan(f_lat, d, s_c, rev)
        ys_lat.append(y_l)
        ys_ctx.append(y_c)
    out_lat = _rwkv_readout(ys_lat[0] + ys_lat[1], f_lat, r_k, ln_w, ln_b)
    out_ctx = _rwkv_readout(ys_ctx[0] + ys_ctx[1], f_ctx, r_k, ln_w, ln_b) if need_ctx_out else None
    return out_lat, out_ctx


def _neighbourhood_attention(q, k, v, qc, kc, vc, rpb, need_ctx_out):
    B, T = q.shape[0], q.shape[1]
    rows = T // GRID_W
    kh = min(NA_ROWS_MAX, rows)
    kw = NA_COLS
    scale = HEAD_DIM ** -0.5
    qg = q.reshape(B, rows, GRID_W, H_NA, HEAD_DIM)
    kg = k.reshape(B, rows, GRID_W, H_NA, HEAD_DIM)
    vg = v.reshape(B, rows, GRID_W, H_NA, HEAD_DIM)
    cols = np.arange(GRID_W)
    col_idx = np.clip(cols - kw // 2, 0, GRID_W - kw)[:, None] + np.arange(kw)[None, :]
    col_off = col_idx - cols[:, None] + (NA_COLS - 1)
    rpb_cols = rpb[:, :, col_off]

    def one_row(r):
        r0 = jnp.clip(r - kh // 2, 0, rows - kh)
        q_row = lax.dynamic_index_in_dim(qg, r, axis=1, keepdims=False)
        k_win = lax.dynamic_slice_in_dim(kg, r0, kh, axis=1)[:, :, col_idx]
        v_win = lax.dynamic_slice_in_dim(vg, r0, kh, axis=1)[:, :, col_idx]
        row_off = r0 + jnp.arange(kh) - r + (NA_ROWS_MAX - 1)
        bias = jnp.take(rpb_cols, row_off, axis=1).transpose(0, 2, 1, 3)
        s_loc = jnp.einsum('bqhd,biqjhd->bhqij', q_row, k_win).astype(jnp.float32) * scale + bias.astype(jnp.float32)
        s_ctx = jnp.einsum('bqhd,blhd->bhql', q_row, kc).astype(jnp.float32) * scale
        s = jnp.concatenate([s_loc.reshape(B, H_NA, GRID_W, kh * kw), s_ctx], axis=-1)
        p = jax.nn.softmax(s, axis=-1).astype(v.dtype)
        p_loc = p[..., :kh * kw].reshape(B, H_NA, GRID_W, kh, kw)
        p_ctx = p[..., kh * kw:]
        return jnp.einsum('bhqij,biqjhd->bqhd', p_loc, v_win) + jnp.einsum('bhql,blhd->bqhd', p_ctx, vc)

    y = lax.map(one_row, jnp.arange(rows))
    y_lat = jnp.moveaxis(y, 0, 1).reshape(B, T, D_NA)
    y_ctx = None
    if need_ctx_out:
        s = jnp.einsum('blhd,bmhd->bhlm', qc, kc).astype(jnp.float32) * scale
        p = jax.nn.softmax(s, axis=-1).astype(vc.dtype)
        y_ctx = jnp.einsum('bhlm,bmhd->blhd', p, vc).reshape(B, qc.shape[1], D_NA)
    return y_lat, y_ctx


def _mixer(h_lat, h_ctx, w_in, shift_mu, w0, w2, a0, a2, g2, k_k, k_a, r_k, ln_w, ln_b, rpb, w_out, need_ctx_out):
    p_lat = h_lat @ w_in
    p_ctx = h_ctx @ w_in
    n_na = 3 * D_NA

    def heads(t):
        return t.reshape(t.shape[0], t.shape[1], H_NA, HEAD_DIM)

    q, k, v = [heads(t) for t in jnp.split(p_lat[..., :n_na], 3, axis=-1)]
    qc, kc, vc = [heads(t) for t in jnp.split(p_ctx[..., :n_na], 3, axis=-1)]
    y_na_lat, y_na_ctx = _neighbourhood_attention(q, k, v, qc, kc, vc, rpb, need_ctx_out)
    u_lat = _centred_shift(p_lat[..., n_na:], shift_mu)
    u_ctx = _centred_shift(p_ctx[..., n_na:], shift_mu)
    y_rw_lat, y_rw_ctx = _rwkv_group(u_lat, u_ctx, w0, w2, a0, a2, g2, k_k, k_a, r_k, ln_w, ln_b, need_ctx_out)
    out_lat = jnp.concatenate([y_rw_lat, y_na_lat], axis=-1) @ w_out
    out_ctx = jnp.concatenate([y_rw_ctx, y_na_ctx], axis=-1) @ w_out if need_ctx_out else None
    return out_lat, out_ctx


def _swiglu(h, w1, w3, w2):
    return (jax.nn.silu(h @ w1) * (h @ w3)) @ w2


def _moe_swiglu(h, router, w1, w3, w2):
    shp = h.shape
    x = h.reshape(-1, shp[-1])
    n, d = x.shape
    logits = (x @ router).astype(jnp.float32)
    top_logit, top_idx = lax.top_k(logits, TOP_K)
    gate = jax.nn.softmax(top_logit, axis=-1)
    a = n * TOP_K
    flat_e = top_idx.reshape(a)
    flat_tok = jnp.broadcast_to(jnp.arange(n, dtype=jnp.int32)[:, None], (n, TOP_K)).reshape(a)
    flat_g = gate.reshape(a)
    order = jnp.argsort(flat_e)
    e_sorted = flat_e[order]
    counts = jnp.bincount(flat_e, length=N_EXPERTS)
    starts = jnp.cumsum(counts) - counts
    padded = (counts + MOE_BLOCK - 1) // MOE_BLOCK * MOE_BLOCK
    pad_ends = jnp.cumsum(padded)
    pad_starts = pad_ends - padded
    dest = pad_starts[e_sorted] + (jnp.arange(a) - starts[e_sorted])
    n_blocks = -(-a // MOE_BLOCK) + N_EXPERTS
    n_slots = n_blocks * MOE_BLOCK
    slot_tok = jnp.full((n_slots,), n, jnp.int32).at[dest].set(flat_tok[order])
    slot_g = jnp.zeros((n_slots,), jnp.float32).at[dest].set(flat_g[order])
    block_e = jnp.minimum(jnp.searchsorted(pad_ends, jnp.arange(n_blocks) * MOE_BLOCK, side='right'), N_EXPERTS - 1)
    x_pad = jnp.concatenate([x, jnp.zeros((1, d), x.dtype)], axis=0)
    xs = x_pad[slot_tok].reshape(n_blocks, MOE_BLOCK, d)

    def run_block(args):
        xb, e = args
        return _swiglu(xb, w1[e], w3[e], w2[e])

    yb = lax.map(run_block, (xs, block_e)).reshape(n_slots, d)
    y = jnp.zeros((n + 1, d), x.dtype).at[slot_tok].add(yb * slot_g[:, None].astype(x.dtype))
    return y[:n].reshape(shp)


def setup_inputs(seed: int = 0) -> dict:
    key = jax.random.key(seed)
    ks = jax.random.split(key, 32)
    f32 = jnp.float32
    n_dense = (DEPTH + 1) // 2
    n_moe = DEPTH // 2

    def nrm(k, shape, s):
        return jax.random.normal(k, shape, f32) * s

    return {
        'x': nrm(ks[0], (BATCH, SEQ, D_MODEL), 1.0),
        'c': nrm(ks[1], (BATCH, D_MODEL), 1.0),
        'ctx': nrm(ks[2], (BATCH, CTX_LEN, D_MODEL), 1.0),
        'c_ctx': nrm(ks[3], (D_MODEL,), 1.0),
        'ada_w': nrm(ks[4], (DEPTH, D_MODEL, 6 * D_MODEL), 0.5 * D_MODEL ** -0.5),
        'ada_b': nrm(ks[5], (DEPTH, 6 * D_MODEL), 0.01),
        'norm_mix_g': 1.0 + nrm(ks[6], (DEPTH, D_MODEL), 0.05),
        'norm_ffn_g': 1.0 + nrm(ks[7], (DEPTH, D_MODEL), 0.05),
        'w_in': nrm(ks[8], (DEPTH, D_MODEL, D_IN), D_MODEL ** -0.5),
        'shift_mu': jax.random.uniform(ks[9], (DEPTH, D_SHIFT), f32),
        'w0': jax.random.uniform(ks[10], (DEPTH, 2, D_RWKV), f32, -6.0, -1.0),
        'w2': nrm(ks[11], (DEPTH, 2, R_DECAY, D_RWKV), 0.5 * R_DECAY ** -0.5),
        'a0': nrm(ks[12], (DEPTH, 2, D_RWKV), 0.1),
        'a2': nrm(ks[13], (DEPTH, 2, R_AAA, D_RWKV), 0.5 * R_AAA ** -0.5),
        'g2': nrm(ks[14], (DEPTH, R_GATE, D_RWKV), R_GATE ** -0.5),
        'k_k': 0.85 + nrm(ks[15], (DEPTH, D_RWKV), 0.05),
        'k_a': 1.0 + nrm(ks[16], (DEPTH, D_RWKV), 0.05),
        'r_k': nrm(ks[17], (DEPTH, H_RWKV, HEAD_DIM), 0.1),
        'ln_x_w': 1.0 + nrm(ks[18], (DEPTH, D_RWKV), 0.05),
        'ln_x_b': nrm(ks[19], (DEPTH, D_RWKV), 0.01),
        'na_rpb': nrm(ks[20], (DEPTH, H_NA, 2 * NA_ROWS_MAX - 1, 2 * NA_COLS - 1), 0.1),
        'w_out': nrm(ks[21], (DEPTH, D_MODEL, D_MODEL), D_MODEL ** -0.5),
        'ffn_w1': nrm(ks[22], (n_dense, D_MODEL, D_FF), D_MODEL ** -0.5),
        'ffn_w3': nrm(ks[23], (n_dense, D_MODEL, D_FF), D_MODEL ** -0.5),
        'ffn_w2': nrm(ks[24], (n_dense, D_FF, D_MODEL), D_FF ** -0.5),
        'router': nrm(ks[25], (n_moe, D_MODEL, N_EXPERTS), D_MODEL ** -0.5),
        'moe_w1': nrm(ks[26], (n_moe, N_EXPERTS, D_MODEL, D_FF_EXPERT), D_MODEL ** -0.5),
        'moe_w3': nrm(ks[27], (n_moe, N_EXPERTS, D_MODEL, D_FF_EXPERT), D_MODEL ** -0.5),
        'moe_w2': nrm(ks[28], (n_moe, N_EXPERTS, D_FF_EXPERT, D_MODEL), D_FF_EXPERT ** -0.5),
        'final_g': 1.0 + nrm(ks[29], (D_MODEL,), 0.05),
    }


def reference(x, c, ctx, c_ctx, ada_w, ada_b, norm_mix_g, norm_ffn_g, w_in, shift_mu, w0, w2, a0, a2, g2,
              k_k, k_a, r_k, ln_x_w, ln_x_b, na_rpb, w_out, ffn_w1, ffn_w3, ffn_w2, router, moe_w1, moe_w3,
              moe_w2, final_g):
    L = ctx.shape[1]
    s_c = jax.nn.silu(c)
    s_cc = jax.nn.silu(c_ctx)
    for l in range(DEPTH):
        last = l == DEPTH - 1
        mod = jnp.split((s_c @ ada_w[l] + ada_b[l])[:, None, :], 6, axis=-1)
        mod_c = jnp.split(s_cc @ ada_w[l] + ada_b[l], 6, axis=-1)
        h = _rms_norm(x, norm_mix_g[l]) * (1.0 + mod[1]) + mod[0]
        hc = _rms_norm(ctx, norm_mix_g[l]) * (1.0 + mod_c[1]) + mod_c[0]
        o, oc = _mixer(h, hc, w_in[l], shift_mu[l], w0[l], w2[l], a0[l], a2[l], g2[l], k_k[l], k_a[l], r_k[l],
                       ln_x_w[l], ln_x_b[l], na_rpb[l], w_out[l], not last)
        x = x + mod[2] * o
        h = _rms_norm(x, norm_ffn_g[l]) * (1.0 + mod[4]) + mod[3]
        if not last:
            ctx = ctx + mod_c[2] * oc
            hc = _rms_norm(ctx, norm_ffn_g[l]) * (1.0 + mod_c[4]) + mod_c[3]
            tokens = jnp.concatenate([hc, h], axis=1)
        else:
            tokens = h
        i = l // 2
        if l % 2 == 0:
            y = _swiglu(tokens, ffn_w1[i], ffn_w3[i], ffn_w2[i])
        else:
            y = _moe_swiglu(tokens, router[i], moe_w1[i], moe_w3[i], moe_w2[i])
        if not last:
            ctx = ctx + mod_c[5] * y[:, :L]
            x = x + mod[5] * y[:, L:]
        else:
            x = x + mod[5] * y
    return _rms_norm(x, final_g)
```

```cpp
#include <hip/hip_runtime.h>
#include <cstdio>
#include <cstdint>

#define GAS __attribute__((address_space(1)))
#define LAS __attribute__((address_space(3)))

#ifndef MK_ONE_LAUNCH
#define MK_ONE_LAUNCH 1
#endif

#ifndef MK_CONV_A
#define MK_CONV_A 70
#endif
#ifndef MK_CONV_B
#define MK_CONV_B 30
#endif
#ifndef MK_CONV_C
#define MK_CONV_C 6
#endif
#ifndef MK_CONV_D
#define MK_CONV_D 6
#endif
#ifndef MK_CONV_E
#define MK_CONV_E 5
#endif

constexpr int BATCH = 16, SEQ = 2048, CTXL = 256, D = 1024, DEPTH = 4;
constexpr int NCTX = BATCH * CTXL;
constexpr int NLAT = BATCH * SEQ;
constexpr int NTOK = NCTX + NLAT;
constexpr int DRW = 512, HD = 64, NH = 8;
constexpr int DSHIFT = 1920, DIN = 3456, DINP = 3072, URW = 1024;
constexpr int DFF = 2816, NEXP = 8, DFFE = 3584;
constexpr int MODW = 6 * D;
constexpr int MOE_GROUP = 64;
constexpr int MOE_NGROUPS = 5;
constexpr int MAXSLOTS = (2 * NTOK / 256 + NEXP) * 256;
constexpr float RMS_EPS = 1e-6f, GN_EPS = 64e-5f;

constexpr size_t MiB = 1u << 20;
constexpr size_t WS_CTL = 0, CTL_BYTES = 1 * MiB;
constexpr size_t WS_MODS = 1 * MiB;
constexpr size_t WS_ROUTE = 3 * MiB;
constexpr size_t WS_SLOTG = 4 * MiB + 512 * 1024;
constexpr size_t WS_G2T = 5 * MiB;
constexpr size_t WS_WIN = 6 * MiB;
constexpr size_t WS_WOUT = 34 * MiB;
constexpr size_t WS_WUP = 42 * MiB;
constexpr size_t WS_WDN = 64 * MiB;
constexpr size_t WS_MUP = 75 * MiB;
constexpr size_t WS_MDN = 187 * MiB;
constexpr size_t WS_XS = 243 * MiB;
constexpr size_t WS_H = 387 * MiB;
constexpr size_t WS_U = 459 * MiB;
constexpr size_t WS_P = WS_U;
constexpr size_t WS_VT = WS_U + 216 * MiB;
constexpr size_t WS_YD = WS_U + 252 * MiB;
constexpr size_t WS_SB = WS_U + 396 * MiB;
constexpr size_t WS_YCAT = WS_U + 399 * MiB;
constexpr size_t WS_DB2 = WS_U + 252 * MiB;
constexpr size_t WS_DB2B = WS_U + 260 * MiB;
constexpr size_t WS_T = WS_U;
constexpr size_t WS_XG = WS_U;
constexpr size_t WS_YS = WS_XG;
constexpr size_t WS_TM = WS_U + 148 * MiB;
constexpr size_t WS_END = 931 * MiB;
constexpr int CW_BAR = 4096;
constexpr int CW_CNT = 8192;

constexpr int LDS_BYTES = 147456;
constexpr int NWAVES = 8, NTHR = 512;

typedef unsigned short bf16;
typedef unsigned v4u __attribute__((ext_vector_type(4)));
typedef unsigned v2u __attribute__((ext_vector_type(2)));
typedef float f32x4 __attribute__((ext_vector_type(4)));
typedef float f32x2 __attribute__((ext_vector_type(2)));

__device__ __forceinline__ float bf2f(unsigned b) { return __uint_as_float(b << 16); }
__device__ __forceinline__ unsigned f2bf(float f) { unsigned u = __float_as_uint(f); return (u + 0x7fffu + ((u >> 16) & 1u)) >> 16; }
__device__ __forceinline__ unsigned pk2(float lo, float hi) { return f2bf(lo) | (f2bf(hi) << 16); }
__device__ __forceinline__ float wave_sum(float v) {
#pragma unroll
    for (int o = 1; o < 64; o <<= 1) v += __shfl_xor(v, o);
    return v;
}
__device__ __forceinline__ float sigmoidf_(float x) { return __builtin_amdgcn_rcpf(1.f + __expf(-x)); }

namespace pg8 {
#define PG8_LAS __attribute__((address_space(3)))
typedef unsigned short bf16_t;
typedef short bf16x8 __attribute__((ext_vector_type(8)));
typedef unsigned u32x4 __attribute__((ext_vector_type(4)));
constexpr int BM = 256, BK = 64, HALF = 128, HTB = HALF * BK * 2, STAGE_BYTES = 8 * HTB, NXCD = 8, WGM = 8;

__host__ __device__ __forceinline__ int lds_byte(int r, int c) { const int st = (r >> 4) * 2 + (c >> 5), rr = r & 15, cc = c & 31, ob = rr * 64 + cc * 2; return st * 1024 + (ob ^ (((ob >> 9) & 1) << 5)); }
__host__ __device__ __forceinline__ void stage_rc(int b, int& R, int& C) { const int st = b / 1024, sb = b % 1024, swz = sb ^ (((sb >> 9) & 1) << 5); R = (st >> 1) * 16 + swz / 64; C = (st & 1) * 32 + (swz % 64) / 2; }
__host__ __device__ __forceinline__ int perm32(int rho) { const int n = rho >> 4, i = rho & 15; return 8 * (i >> 2) + 4 * n + (i & 3); }

struct Unit { int pm, pn; };

struct SchedS {
    int nM, nN, nwg, G, c, pm0; const char* A; const char* Bt; size_t ats, bts;
    __device__ __forceinline__ void init(const void* A_, const void* Bt_, int K, int pm0_, int nM_, int nN_, int G_, int c_) {
        A = (const char*)A_; Bt = (const char*)Bt_; ats = (size_t)BM * K * 2; bts = ats; pm0 = pm0_; nM = nM_ > 0 ? nM_ : 0; nN = nN_; nwg = nM * nN; G = G_; c = c_; }
    __device__ __forceinline__ bool unit_of(long L, Unit& u) const {
        if (L >= nwg) return false;
        int wgid = (int)L; { const int q = nwg / NXCD, r = nwg % NXCD, xcd = wgid % NXCD, off = wgid / NXCD; wgid = (xcd < r ? xcd * (q + 1) : r * (q + 1) + (xcd - r) * q) + off; }
        const int nig = WGM * nN, gid = wgid / nig, fm = gid * WGM, gsz = (nM - fm) < WGM ? (nM - fm) : WGM;
        u.pm = pm0 + fm + ((wgid % nig) % gsz); u.pn = (wgid % nig) / gsz; return true;
    }
    __device__ __forceinline__ bool next(int i, Unit& u) const { return unit_of((long)i * G + c, u); }
    __device__ __forceinline__ const char* a_base(const Unit& u) const { return A + (size_t)u.pm * ats; }
    __device__ __forceinline__ const char* b_base(const Unit& u) const { return Bt + (size_t)u.pn * bts; }
    __device__ __forceinline__ void a_ready(const Unit&) const {}
    __device__ __forceinline__ void done(const Unit&) const {}
};
struct SchedK2 : SchedS {
    size_t khb;
    __device__ __forceinline__ const char* a_base(const Unit& u) const { return A + (size_t)u.pm * ats + (size_t)(u.pn & 1) * khb; }
    __device__ __forceinline__ const char* b_base(const Unit& u) const { return Bt + (size_t)(u.pn >> 1) * bts + (size_t)(u.pn & 1) * khb; }
};
struct SchedE : SchedS {
    int tend[8]; int asub; size_t bes;
    const PG8_LAS int* list;
    __device__ __forceinline__ bool next(int i, Unit& u) const { if (i >= 64) return false; return unit_of((long)__builtin_amdgcn_readfirstlane(list[i]), u); }
    __device__ __forceinline__ const char* a_base(const Unit& u) const { return A + (size_t)(u.pm - asub) * ats; }
    __device__ __forceinline__ const char* b_base(const Unit& u) const {
        int e = 0;
#pragma unroll
        for (int j = 0; j < 7; ++j) e += (u.pm >= tend[j]) ? 1 : 0;
        return Bt + (size_t)e * bes + (size_t)u.pn * bts; }
};

typedef __bf16 bf16x2_t __attribute__((ext_vector_type(2)));
__device__ __forceinline__ unsigned cvt_pk_bf16(float lo, float hi) { const float __attribute__((ext_vector_type(2))) v = {lo, hi}; return __builtin_bit_cast(unsigned, __builtin_convertvector(v, bf16x2_t)); }

struct EpiP {
    static constexpr bool PERM = true, AFTER_DRAIN = false;
    bf16_t* O; int ldc;
    __device__ __forceinline__ void operator()(const f32x4 (&acc)[2][2][4][2], const Unit& u, int wr, int wc, int fr, int fq) const {
        const int row0 = u.pm * BM + wr * 64 + fr, col0 = u.pn * BM + wc * 32 + 8 * fq;
#pragma unroll
        for (int ai = 0; ai < 2; ++ai)
#pragma unroll
            for (int m = 0; m < 4; ++m) { bf16_t* rowp = O + (size_t)(row0 + ai * HALF + m * 16) * ldc + col0;
#pragma unroll
                for (int bj = 0; bj < 2; ++bj) { const f32x4 v0 = acc[ai][bj][m][0], v1 = acc[ai][bj][m][1];
                    u32x4 w; w.x = cvt_pk_bf16(v0[0], v0[1]); w.y = cvt_pk_bf16(v0[2], v0[3]); w.z = cvt_pk_bf16(v1[0], v1[1]); w.w = cvt_pk_bf16(v1[2], v1[3]);
                    *(u32x4*)(rowp + bj * HALF) = w; } }
    }
};
struct SchedIn {
    int G, c; const char* Hm; const char* W;
    __device__ __forceinline__ bool next(int i, Unit& u) const {
        const int L = i * G + c; if (L >= 2016) return false;
        if (L < 1728) { int wgid = L; { const int q = 1728 / NXCD, xcd = wgid % NXCD, off = wgid / NXCD; wgid = xcd * q + off; }
            const int nig = WGM * 12, gid = wgid / nig, fm = gid * WGM; u.pm = fm + ((wgid % nig) % WGM); u.pn = (wgid % nig) / WGM; }
        else { const int L2 = L - 1728; u.pm = 1000 + (L2 & 1); u.pn = L2 >> 1; }
        return true; }
    __device__ __forceinline__ const char* a_base(const Unit& u) const { return u.pm >= 1000 ? W + (size_t)(3072 + (u.pm - 1000) * 256) * 2048 : Hm + (size_t)u.pm * 256 * 2048; }
    __device__ __forceinline__ const char* b_base(const Unit& u) const { return u.pm >= 1000 ? Hm + (size_t)u.pn * 256 * 2048 : W + (size_t)u.pn * 256 * 2048; }
    __device__ __forceinline__ void a_ready(const Unit&) const {}
    __device__ __forceinline__ void done(const Unit&) const {}
};
struct EpiIn {
    static constexpr bool PERM = true, AFTER_DRAIN = false;
    bf16_t* P; bf16_t* VT;
    __device__ __forceinline__ void operator()(const f32x4 (&acc)[2][2][4][2], const Unit& u, int wr, int wc, int fr, int fq) const {
        const bool tr = u.pm >= 1000; bf16_t* O = tr ? VT : P; const int ldc = tr ? 36864 : 3072, pm = tr ? u.pm - 1000 : u.pm;
        const int row0 = pm * BM + wr * 64 + fr, col0 = u.pn * BM + wc * 32 + 8 * fq;
#pragma unroll
        for (int ai = 0; ai < 2; ++ai)
#pragma unroll
            for (int m = 0; m < 4; ++m) { bf16_t* rowp = O + (size_t)(row0 + ai * HALF + m * 16) * ldc + col0;
#pragma unroll
                for (int bj = 0; bj < 2; ++bj) { const f32x4 v0 = acc[ai][bj][m][0], v1 = acc[ai][bj][m][1];
                    u32x4 w; w.x = cvt_pk_bf16(v0[0], v0[1]); w.y = cvt_pk_bf16(v0[2], v0[3]); w.z = cvt_pk_bf16(v1[0], v1[1]); w.w = cvt_pk_bf16(v1[2], v1[3]);
                    *(u32x4*)(rowp + bj * HALF) = w; } }
    }
};
struct EpiSwi {
    static constexpr bool PERM = true, AFTER_DRAIN = false;
    bf16_t* O; int ldc; int tsub;
    __device__ __forceinline__ void operator()(const f32x4 (&acc)[2][2][4][2], const Unit& u, int wr, int wc, int fr, int fq) const {
        const int row0 = (u.pm - tsub) * BM + wr * 64 + fr, col0 = u.pn * HALF + wc * 32 + 8 * fq;
#pragma unroll
        for (int ai = 0; ai < 2; ++ai)
#pragma unroll
            for (int m = 0; m < 4; ++m) { bf16_t* rowp = O + (size_t)(row0 + ai * HALF + m * 16) * ldc + col0;
                float t[8];
#pragma unroll
                for (int n = 0; n < 2; ++n)
#pragma unroll
                    for (int j = 0; j < 4; ++j) { const float g = acc[ai][0][m][n][j], up = acc[ai][1][m][n][j]; t[n * 4 + j] = g * __builtin_amdgcn_rcpf(1.f + __expf(-g)) * up; }
                u32x4 w; w.x = cvt_pk_bf16(t[0], t[1]); w.y = cvt_pk_bf16(t[2], t[3]); w.z = cvt_pk_bf16(t[4], t[5]); w.w = cvt_pk_bf16(t[6], t[7]);
                *(u32x4*)rowp = w; }
    }
};
template <bool BASEF32>
struct EpiRes {
    static constexpr bool PERM = true, AFTER_DRAIN = false;
    bf16_t* out; const void* base_ctx; const void* base_lat; const float* mods_l; int mcol;
    __device__ __forceinline__ void operator()(const f32x4 (&acc)[2][2][4][2], const Unit& u, int wr, int wc, int fr, int fq) const {
        const bool isctx = u.pm < 16;
        const size_t toff = isctx ? (size_t)u.pm * BM * 1024 : (size_t)(u.pm - 16) * BM * 1024;
        const float* gate = mods_l + (isctx ? 16 : ((u.pm - 16) >> 3)) * 6144 + mcol;
        bf16_t* o = out + (size_t)u.pm * BM * 1024;
        const int r0 = wr * 64 + fr, col0 = u.pn * BM + wc * 32 + 8 * fq;
        f32x4 gv[2][2];
#pragma unroll
        for (int bj = 0; bj < 2; ++bj)
#pragma unroll
            for (int n = 0; n < 2; ++n) gv[bj][n] = *(const f32x4*)(gate + col0 + bj * HALF + n * 4);
#pragma unroll
        for (int ai = 0; ai < 2; ++ai)
#pragma unroll
            for (int m0 = 0; m0 < 4; m0 += 4) {
                u32x4 wpre[4][2];
                if constexpr (!BASEF32) {
#pragma unroll
                    for (int mm = 0; mm < 4; ++mm)
#pragma unroll
                        for (int bj = 0; bj < 2; ++bj) wpre[mm][bj] = *(const u32x4*)((const bf16_t*)(isctx ? base_ctx : base_lat) + toff + (size_t)(r0 + ai * HALF + (m0 + mm) * 16) * 1024 + col0 + bj * HALF); }
#pragma unroll
                for (int mm = 0; mm < 4; ++mm) { const int m = m0 + mm; const size_t ro = (size_t)(r0 + ai * HALF + m * 16) * 1024 + col0;
#pragma unroll
                for (int bj = 0; bj < 2; ++bj) { f32x4 b0, b1;
                    if constexpr (BASEF32) { const float* b = (const float*)(isctx ? base_ctx : base_lat) + toff + ro + bj * HALF; b0 = *(const f32x4*)b; b1 = *(const f32x4*)(b + 4); }
                    else { const u32x4 w = wpre[mm][bj];
                        b0 = (f32x4){__uint_as_float(w.x << 16), __uint_as_float(w.x & 0xffff0000u), __uint_as_float(w.y << 16), __uint_as_float(w.y & 0xffff0000u)};
                        b1 = (f32x4){__uint_as_float(w.z << 16), __uint_as_float(w.z & 0xffff0000u), __uint_as_float(w.w << 16), __uint_as_float(w.w & 0xffff0000u)}; }
                    const f32x4 v0 = b0 + gv[bj][0] * acc[ai][bj][m][0], v1 = b1 + gv[bj][1] * acc[ai][bj][m][1];
                    u32x4 w; w.x = cvt_pk_bf16(v0[0], v0[1]); w.y = cvt_pk_bf16(v0[2], v0[3]); w.z = cvt_pk_bf16(v1[0], v1[1]); w.w = cvt_pk_bf16(v1[2], v1[3]);
                    *(u32x4*)(o + ro + bj * HALF) = w; } } }
    }
};
struct EpiDelta {
    static constexpr bool PERM = true, AFTER_DRAIN = false;
    bf16_t* Ob; size_t o2off; const float* mods_l; int mcol;
    __device__ __forceinline__ void operator()(const f32x4 (&acc)[2][2][4][2], const Unit& u, int wr, int wc, int fr, int fq) const {
        const float* gate = mods_l + (u.pm < 16 ? 16 : ((u.pm - 16) >> 3)) * 6144 + mcol;
        bf16_t* O = Ob + (size_t)(u.pn & 1) * o2off;
        const int row0 = u.pm * BM + wr * 64 + fr, col0 = (u.pn >> 1) * BM + wc * 32 + 8 * fq;
        f32x4 gv[2][2];
#pragma unroll
        for (int bj = 0; bj < 2; ++bj)
#pragma unroll
            for (int n = 0; n < 2; ++n) gv[bj][n] = *(const f32x4*)(gate + col0 + bj * HALF + n * 4);
#pragma unroll
        for (int ai = 0; ai < 2; ++ai)
#pragma unroll
            for (int m = 0; m < 4; ++m) { bf16_t* rowp = O + (size_t)(row0 + ai * HALF + m * 16) * 1024 + col0;
#pragma unroll
                for (int bj = 0; bj < 2; ++bj) { const f32x4 v0 = acc[ai][bj][m][0] * gv[bj][0], v1 = acc[ai][bj][m][1] * gv[bj][1];
                    u32x4 w; w.x = cvt_pk_bf16(v0[0], v0[1]); w.y = cvt_pk_bf16(v0[2], v0[3]); w.z = cvt_pk_bf16(v1[0], v1[1]); w.w = cvt_pk_bf16(v1[2], v1[3]);
                    *(u32x4*)(rowp + bj * HALF) = w; } }
    }
};
struct EpiMoeDn {
    static constexpr bool PERM = true, AFTER_DRAIN = false;
    bf16_t* O; const float* slotg;
    __device__ __forceinline__ void operator()(const f32x4 (&acc)[2][2][4][2], const Unit& u, int wr, int wc, int fr, int fq) const {
        const int row0 = u.pm * BM + wr * 64 + fr, col0 = u.pn * BM + wc * 32 + 8 * fq;
        float gs[2][4];
#pragma unroll
        for (int ai = 0; ai < 2; ++ai)
#pragma unroll
            for (int m = 0; m < 4; ++m) gs[ai][m] = slotg[row0 + ai * HALF + m * 16];
#pragma unroll
        for (int ai = 0; ai < 2; ++ai)
#pragma unroll
            for (int m = 0; m < 4; ++m) { const int row = row0 + ai * HALF + m * 16; const float g = gs[ai][m]; bf16_t* rowp = O + (size_t)row * 1024 + col0;
#pragma unroll
                for (int bj = 0; bj < 2; ++bj) { const f32x4 v0 = acc[ai][bj][m][0] * g, v1 = acc[ai][bj][m][1] * g;
                    u32x4 w; w.x = cvt_pk_bf16(v0[0], v0[1]); w.y = cvt_pk_bf16(v0[2], v0[3]); w.z = cvt_pk_bf16(v1[0], v1[1]); w.w = cvt_pk_bf16(v1[2], v1[3]);
                    *(u32x4*)(rowp + bj * HALF) = w; } }
    }
};

template <class Epi, class Sched, bool ALIGN_EPI = true>
__device__ __forceinline__ void gemm_phase(PG8_LAS unsigned char* lds, const int K, const Sched& S, const Epi& E, const int ldk_ = 0) {
    const int ldk = ldk_ ? ldk_ : K;
    const int tid = threadIdx.x, wid = __builtin_amdgcn_readfirstlane(tid >> 6), lane = tid & 63, wr = wid >> 2, wc = wid & 3, fr = lane & 15, fq = lane >> 4;
    const int nt = K / BK;
    unsigned voffA[2], voffB[2];
#pragma unroll
    for (int i = 0; i < 2; ++i) { int R, C; stage_rc(tid * 16 + i * 8192, R, C); const int Rb = Epi::PERM ? ((R & ~31) + perm32(R & 31)) : R;
        voffA[i] = (unsigned)(R * ldk + C) * 2u; voffB[i] = (unsigned)(Rb * ldk + C) * 2u; }
    const size_t kstep = (size_t)(BK * 2);
    const size_t hstep = (size_t)HALF * ldk * 2;
    const unsigned ldsw = (unsigned)wid * 1024u;
    const int aoff = lds_byte(wr * 64 + fr, fq * 8), boff = lds_byte(wc * 32 + fr, fq * 8);
#define PG8_SA(b, h) (((b) * 2 + (h)) * HTB)
#define PG8_SB(b, h) ((4 + (b) * 2 + (h)) * HTB)
#define PG8_STAGE(bufoff, gbase, voff) do { _Pragma("unroll") for (int _i = 0; _i < 2; ++_i) \
        __builtin_amdgcn_global_load_lds((const unsigned*)((const char*)(gbase) + (voff)[_i]), (PG8_LAS unsigned*)(lds + (bufoff) + ldsw + _i * 8192), 16, 0, 0); } while (0)
#define PG8_LDA(dst, b, h) do { _Pragma("unroll") for (int m = 0; m < 4; ++m) _Pragma("unroll") for (int k = 0; k < 2; ++k) dst[m][k] = *(const PG8_LAS bf16x8*)(lds + PG8_SA(b, h) + aoff + m * 2048 + k * 1024); } while (0)
#define PG8_LDB(dst, b, h) do { _Pragma("unroll") for (int n = 0; n < 2; ++n) _Pragma("unroll") for (int k = 0; k < 2; ++k) dst[n][k] = *(const PG8_LAS bf16x8*)(lds + PG8_SB(b, h) + boff + n * 2048 + k * 1024); } while (0)
#define PG8_MMA(ai, bj, At, Bt) do { __builtin_amdgcn_s_setprio(1); _Pragma("unroll") for (int m = 0; m < 4; ++m) _Pragma("unroll") for (int n = 0; n < 2; ++n) _Pragma("unroll") for (int k = 0; k < 2; ++k) \
        acc[ai][bj][m][n] = __builtin_amdgcn_mfma_f32_16x16x32_bf16(Bt[n][k], At[m][k], acc[ai][bj][m][n], 0, 0, 0); __builtin_amdgcn_s_setprio(0); } while (0)
#define PG8_WAIT_V(n) asm volatile("s_waitcnt vmcnt(" #n ")" ::: "memory")
#define PG8_WAIT_L(n) asm volatile("s_waitcnt lgkmcnt(" #n ")" ::: "memory")
#define PG8_BAR __builtin_amdgcn_s_barrier()
#define PG8_SCHED __builtin_amdgcn_sched_barrier(0)
    Unit cur, nxt; int ui = 0;
    if (!S.next(0, cur)) return;
    f32x4 acc[2][2][4][2];
#pragma unroll
    for (int a = 0; a < 2; ++a)
#pragma unroll
        for (int b = 0; b < 2; ++b)
#pragma unroll
            for (int m = 0; m < 4; ++m)
#pragma unroll
                for (int n = 0; n < 2; ++n) acc[a][b][m][n] = (f32x4){0.f, 0.f, 0.f, 0.f};
    bf16x8 At[4][2], B0[2][2], B1[2][2];
    const char* cA = S.a_base(cur); const char* cB = S.b_base(cur);
    S.a_ready(cur);
    PG8_STAGE(PG8_SB(0, 0), cB, voffB); PG8_STAGE(PG8_SB(0, 1), cB + hstep, voffB); PG8_STAGE(PG8_SA(0, 0), cA, voffA); PG8_STAGE(PG8_SA(0, 1), cA + hstep, voffA);
    if (wr == 1) PG8_BAR;
    PG8_WAIT_V(2); PG8_BAR;
    PG8_STAGE(PG8_SB(1, 0), cB + kstep, voffB); PG8_STAGE(PG8_SA(1, 0), cA + kstep, voffA); PG8_STAGE(PG8_SB(1, 1), cB + hstep + kstep, voffB);
    PG8_WAIT_V(6); PG8_BAR;
    for (;;) {
        const bool has_next = S.next(ui + 1, nxt);
        const char* nA = has_next ? S.a_base(nxt) : cA; const char* nB = has_next ? S.b_base(nxt) : cB;
        for (int t = 0; t < nt; t += 2) {
            const bool last = (t == nt - 2);
            const char* a1 = cA + (size_t)(t + 1) * kstep;
            const char* a2 = last ? nA : cA + (size_t)(t + 2) * kstep; const char* b2 = last ? nB : cB + (size_t)(t + 2) * kstep;
            const char* a3 = a2 + kstep; const char* b3 = b2 + kstep;
            if (last && has_next) S.a_ready(nxt);
            PG8_LDB(B0, 0, 0); PG8_LDB(B1, 0, 1); PG8_SCHED; PG8_LDA(At, 0, 0); PG8_STAGE(PG8_SA(1, 1), a1 + hstep, voffA);
            PG8_WAIT_V(8); PG8_WAIT_L(0); PG8_BAR; PG8_MMA(0, 0, At, B0); PG8_MMA(0, 1, At, B1); PG8_BAR; PG8_SCHED;
            PG8_LDA(At, 0, 1); PG8_STAGE(PG8_SB(0, 0), b2, voffB); PG8_STAGE(PG8_SB(0, 1), b2 + hstep, voffB); PG8_STAGE(PG8_SA(0, 0), a2, voffA);
            PG8_WAIT_V(8); PG8_WAIT_L(0); PG8_BAR; PG8_MMA(1, 0, At, B0); PG8_MMA(1, 1, At, B1); PG8_BAR; PG8_SCHED;
            PG8_LDB(B0, 1, 0); PG8_LDB(B1, 1, 1); PG8_SCHED; PG8_LDA(At, 1, 0); PG8_STAGE(PG8_SA(0, 1), a2 + hstep, voffA);
            PG8_WAIT_V(8); PG8_WAIT_L(0); PG8_BAR; PG8_MMA(0, 0, At, B0); PG8_MMA(0, 1, At, B1); PG8_BAR; PG8_SCHED;
            PG8_LDA(At, 1, 1); PG8_STAGE(PG8_SB(1, 0), b3, voffB); PG8_STAGE(PG8_SB(1, 1), b3 + hstep, voffB); PG8_STAGE(PG8_SA(1, 0), a3, voffA);
            PG8_WAIT_V(8); PG8_WAIT_L(0); PG8_BAR; PG8_MMA(1, 0, At, B0); PG8_MMA(1, 1, At, B1); PG8_BAR; PG8_SCHED;
        }
        if constexpr (ALIGN_EPI) { if (wr == 0) PG8_BAR; }
        E(acc, cur, wr, wc, fr, fq); S.done(cur);
        if (!has_next) break;
#pragma unroll
        for (int a = 0; a < 2; ++a)
#pragma unroll
            for (int b = 0; b < 2; ++b)
#pragma unroll
                for (int m = 0; m < 4; ++m)
#pragma unroll
                    for (int n = 0; n < 2; ++n) acc[a][b][m][n] = (f32x4){0.f, 0.f, 0.f, 0.f};
        cur = nxt; cA = nA; cB = nB; ++ui;
        if constexpr (ALIGN_EPI) { if (wr == 1) PG8_BAR; }
    }
    PG8_WAIT_V(0);
    if constexpr (!ALIGN_EPI) { if (wr == 0) PG8_BAR; }
    PG8_BAR;
#undef PG8_SA
#undef PG8_SB
#undef PG8_STAGE
#undef PG8_LDA
#undef PG8_LDB
#undef PG8_MMA
#undef PG8_WAIT_V
#undef PG8_WAIT_L
#undef PG8_BAR
#undef PG8_SCHED
}
}

#define XB_TMO      128
#define XB_XCNT(j)  (256  + 64 * (j))
#define XB_XSUB(j)  (1280 + 64 * (j))
#define XB_XGEN(j)  (2304 + 64 * (j))
#define XB_TOP      3328
#define XB_TOPGEN   3392
#define XCD_BAR_WORDS 3456
#define XB_SPIN_CAP (1u << 18)

__device__ __forceinline__ unsigned xb_ld(unsigned* p)              { return __hip_atomic_load(p, __ATOMIC_RELAXED, __HIP_MEMORY_SCOPE_AGENT); }
__device__ __forceinline__ unsigned xb_add(unsigned* p, unsigned v) { return __hip_atomic_fetch_add(p, v, __ATOMIC_RELAXED, __HIP_MEMORY_SCOPE_AGENT); }
__device__ __forceinline__ unsigned xb_xcc_id() { return (unsigned)__builtin_amdgcn_s_getreg((3 << 11) | 20) & 0xFu; }
#define XB_SPIN(cond, bar) do { unsigned _sp = 0; while (cond) { __builtin_amdgcn_s_sleep(1); \
    if ((++_sp & 255u) == 0u) { if (xb_ld(&(bar)[XB_TMO])) break; if (_sp > XB_SPIN_CAP) { atomicAdd(&(bar)[XB_TMO], 1u); break; } } } } while (0)

struct XcdBarrier { unsigned* bar; unsigned x; volatile LAS unsigned* st; };

__device__ __forceinline__ XcdBarrier xcd_barrier_post(unsigned* bar, volatile LAS unsigned* st) {
    XcdBarrier b; b.bar = bar; b.x = xb_xcc_id(); b.st = st;
    if (threadIdx.x == 0) (void)xb_add(&bar[XB_XCNT(b.x)], 1u);
    return b;
}
__device__ __forceinline__ void xcd_barrier_complete(unsigned* bar, unsigned x, unsigned& nloc, unsigned& nx) {
    const unsigned G = gridDim.x * gridDim.y * gridDim.z;
    unsigned sum, cnt, mine, sp = 0u;
    for (;;) {
        sum = 0u; cnt = 0u; mine = 0u;
#pragma unroll
        for (unsigned j = 0; j < 16; ++j) { const unsigned c = xb_ld(&bar[XB_XCNT(j)]); sum += c; cnt += (c > 0u) ? 1u : 0u; mine = (j == x) ? c : mine; }
        if (sum == G) break;
        __builtin_amdgcn_s_sleep(1);
        if ((++sp & 255u) == 0u) { if (xb_ld(&bar[XB_TMO])) break; if (sp > XB_SPIN_CAP) { atomicAdd(&bar[XB_TMO], 1u); break; } }
    }
    nloc = mine > 0u ? mine : 1u; nx = cnt > 0u ? cnt : 1u;
}
__device__ __forceinline__ void xcd_barrier(const XcdBarrier& b) {
    asm volatile("s_waitcnt vmcnt(0)" ::: "memory");
    __syncthreads();
    if (threadIdx.x == 0) {
        unsigned* bar = b.bar;
        __builtin_amdgcn_s_waitcnt(0);
        unsigned nloc = b.st[0], nx = b.st[1];
        if (nloc == 0u) { xcd_barrier_complete(bar, b.x, nloc, nx); b.st[0] = nloc; b.st[1] = nx; }
        const unsigned old = xb_add(&bar[XB_XSUB(b.x)], 1u);
        const unsigned gen = old / nloc;
        if (old + 1u == (gen + 1u) * nloc) {
            __builtin_amdgcn_fence(__ATOMIC_RELEASE, "agent");
            asm volatile("s_waitcnt vmcnt(0)" ::: "memory");
            const unsigned og = xb_add(&bar[XB_TOP], 1u);
            const unsigned tg = og / nx;
            if (og + 1u == (tg + 1u) * nx) xb_add(&bar[XB_TOPGEN], 1u);
            else XB_SPIN(xb_ld(&bar[XB_TOPGEN]) == tg, bar);
            __builtin_amdgcn_fence(__ATOMIC_ACQUIRE, "agent");
            xb_add(&bar[XB_XGEN(b.x)], 1u);
            asm volatile("s_waitcnt vmcnt(0)" ::: "memory");
        } else {
            XB_SPIN(xb_ld(&bar[XB_XGEN(b.x)]) == gen, bar);
            __builtin_amdgcn_fence(__ATOMIC_ACQUIRE, "agent");
            asm volatile("s_waitcnt vmcnt(0)" ::: "memory");
        }
    }
    __syncthreads();
}

struct Args { const float* in[30]; float* out; unsigned char* ws; int ph_lo, ph_hi; };
enum { I_X = 0, I_C, I_CTX, I_CCTX, I_ADAW, I_ADAB, I_NMG, I_NFG, I_WIN, I_MU, I_W0, I_W2, I_A0, I_A2, I_G2, I_KK, I_KA, I_RK, I_LNW, I_LNB, I_RPB, I_WOUT,
       I_FW1, I_FW3, I_FW2, I_ROUTER, I_MW1, I_MW3, I_MW2, I_FING };

__device__ __forceinline__ void transpose_item(const float* W, int K, int ldw, int ncols, bf16* WT, int mode, LAS float* scr, int item, int lane) {
    const int N = ldw; const int nblk = ncols / 32, kb = item / nblk, nb = item % nblk, k0 = 64 * kb, n0 = 32 * nb;
    { f32x4 v[8]; const int n4 = (lane & 7) * 4;
#pragma unroll
        for (int i = 0; i < 8; ++i) v[i] = *(const f32x4*)(W + (size_t)(k0 + 8 * i + (lane >> 3)) * N + n0 + n4);
#pragma unroll
        for (int i = 0; i < 8; ++i) { LAS float* d = scr + (8 * i + (lane >> 3)) * 33 + n4; d[0] = v[i].x; d[1] = v[i].y; d[2] = v[i].z; d[3] = v[i].w; } }
    asm volatile("s_waitcnt lgkmcnt(0)" ::: "memory");
    const int c = lane & 7;
    const int r0 = (mode == 0) ? n0 : (256 * (n0 >> 7) + (n0 & 127) + (mode == 2 ? 128 : 0));
#pragma unroll
    for (int j = 0; j < 4; ++j) { const int n = (lane >> 3) + 8 * j; const LAS float* s = scr + (8 * c) * 33 + n;
        v4u o; o.x = pk2(s[0 * 33], s[1 * 33]); o.y = pk2(s[2 * 33], s[3 * 33]); o.z = pk2(s[4 * 33], s[5 * 33]); o.w = pk2(s[6 * 33], s[7 * 33]);
        *(v4u*)(WT + (size_t)(r0 + n) * K + k0 + 8 * c) = o; }
    asm volatile("s_waitcnt lgkmcnt(0)" ::: "memory");
}
__device__ __forceinline__ void convert_matrix(const float* W, int K, int ldw, int ncols, bf16* WT, int mode, LAS float* scr, int& gw, int NGW, int lane) {
    const int nitems = (K / 64) * (ncols / 32);
    for (int it = gw; it < nitems; it += NGW) transpose_item(W, K, ldw, ncols, WT, mode, scr, it, lane);
    gw = (gw + NGW - nitems % NGW) % NGW;
}
constexpr int MOE_CONV_ITEMS = 24 * 16 * 112;
__device__ __forceinline__ void convert_moe_range(const Args& a, int i, unsigned char* lds, int it_lo, int it_hi, int cw, int ncw, int wave, int lane) {
    LAS float* scr = (LAS float*)((LAS unsigned char*)lds + wave * 16384);
    bf16* MUP = (bf16*)(a.ws + WS_MUP); bf16* MDN = (bf16*)(a.ws + WS_MDN);
    constexpr int IT = 16 * 112;
    for (int it = it_lo + cw; it < it_hi; it += ncw) {
        const int job = it / IT, r = it % IT, e = job / 3, w = job % 3;
        const size_t eoff = ((size_t)i * NEXP + e) * (size_t)D * DFFE;
        if (w == 0) transpose_item(a.in[I_MW1] + eoff, D, DFFE, DFFE, MUP + (size_t)e * 7168 * 1024, 1, scr, r, lane);
        else if (w == 1) transpose_item(a.in[I_MW3] + eoff, D, DFFE, DFFE, MUP + (size_t)e * 7168 * 1024, 2, scr, r, lane);
        else transpose_item(a.in[I_MW2] + eoff, DFFE, D, D, MDN + (size_t)e * 1024 * 3584, 0, scr, r, lane);
    }
}
__device__ __forceinline__ void prologue_phase(const Args& a, unsigned char* lds, int G) {
    const int tid = threadIdx.x, lane = tid & 63, wave = tid >> 6;
    int gw = blockIdx.x * NWAVES + wave; const int NGW = G * NWAVES;
    {
        LAS float* sc = (LAS float*)lds;
        LAS float* red = (LAS float*)lds + 17 * 1024;
        for (int i = tid; i < 17 * 1024; i += NTHR) { const int r = i >> 10, k = i & 1023; const float v = (r < 16) ? a.in[I_C][r * 1024 + k] : a.in[I_CCTX][k]; sc[i] = v * sigmoidf_(v); }
        __syncthreads();
        float* MODS = (float*)(a.ws + WS_MODS);
        for (int it = blockIdx.x; it < DEPTH * 48; it += G) {
            const int l = it / 48, cb = it % 48, cp = tid & 63, ks = tid >> 6;
            const float* w = a.in[I_ADAW] + (size_t)l * 1024 * MODW + cb * 128 + cp * 2;
            float acc[17][2];
#pragma unroll
            for (int r = 0; r < 17; ++r) { acc[r][0] = 0.f; acc[r][1] = 0.f; }
            for (int k0 = ks * 128; k0 < ks * 128 + 128; k0 += 16) {
                f32x2 wv[16];
#pragma unroll
                for (int u = 0; u < 16; ++u) wv[u] = *(const f32x2*)(w + (size_t)(k0 + u) * MODW);
                __builtin_amdgcn_sched_barrier(0);
#pragma unroll
                for (int u = 0; u < 16; ++u)
#pragma unroll
                    for (int r = 0; r < 17; ++r) { const float s = sc[r * 1024 + k0 + u]; acc[r][0] += s * wv[u].x; acc[r][1] += s * wv[u].y; } }
#pragma unroll
            for (int r = 0; r < 17; ++r) { red[(ks * 17 + r) * 128 + cp * 2] = acc[r][0]; red[(ks * 17 + r) * 128 + cp * 2 + 1] = acc[r][1]; }
            __syncthreads();
            for (int i = tid; i < 17 * 128; i += NTHR) { const int r = i >> 7, c = i & 127; float s = a.in[I_ADAB][l * MODW + cb * 128 + c];
#pragma unroll
                for (int q = 0; q < 8; ++q) s += red[(q * 17 + r) * 128 + c];
                MODS[((size_t)l * 17 + r) * MODW + cb * 128 + c] = s; }
            __syncthreads();
        }
    }
    __syncthreads();
    LAS float* scr = (LAS float*)((LAS unsigned char*)lds + wave * 16384);
    for (int l = 0; l < DEPTH; ++l) {
        bf16* win = (bf16*)(a.ws + WS_WIN) + (size_t)l * 3584 * 1024; const float* wsrc = a.in[I_WIN] + (size_t)l * D * DIN;
        convert_matrix(wsrc, D, DIN, 1024, win, 0, scr, gw, NGW, lane);
        convert_matrix(wsrc + 1536, D, DIN, 1920, win + (size_t)1024 * 1024, 0, scr, gw, NGW, lane);
        for (int i = gw * 64 + lane; i < 128 * 1024 / 8; i += NGW * 64) *(v4u*)(win + (size_t)2944 * 1024 + (size_t)i * 8) = (v4u){0u, 0u, 0u, 0u};
        convert_matrix(wsrc + 1024, D, DIN, 512, win + (size_t)3072 * 1024, 0, scr, gw, NGW, lane);
        convert_matrix(a.in[I_WOUT] + (size_t)l * D * D, D, D, D, (bf16*)(a.ws + WS_WOUT) + (size_t)l * D * D, 0, scr, gw, NGW, lane);
        convert_matrix(a.in[I_G2] + (size_t)l * 128 * DRW, 128, DRW, DRW, (bf16*)(a.ws + WS_G2T) + (size_t)l * DRW * 128, 0, scr, gw, NGW, lane);
    }
    for (int i = 0; i < 2; ++i) {
        bf16* wup = (bf16*)(a.ws + WS_WUP) + (size_t)i * 5632 * 1024;
        convert_matrix(a.in[I_FW1] + (size_t)i * D * DFF, D, DFF, DFF, wup, 1, scr, gw, NGW, lane);
        convert_matrix(a.in[I_FW3] + (size_t)i * D * DFF, D, DFF, DFF, wup, 2, scr, gw, NGW, lane);
        convert_matrix(a.in[I_FW2] + (size_t)i * DFF * D, DFF, D, D, (bf16*)(a.ws + WS_WDN) + (size_t)i * 1024 * DFF, 0, scr, gw, NGW, lane);
    }
}

__device__ __forceinline__ void row_modnorm_store(const f32x4 (&v)[4], const float* gain, const float* shift, const float* scale, bf16* hrow, int lane, f32x4 (&h)[4]) {
    float ss = 0.f;
#pragma unroll
    for (int j = 0; j < 4; ++j) ss += (v[j].x * v[j].x + v[j].y * v[j].y) + (v[j].z * v[j].z + v[j].w * v[j].w);
    const float rstd = rsqrtf(wave_sum(ss) * (1.f / D) + RMS_EPS);
#pragma unroll
    for (int j = 0; j < 4; ++j) { const int c = 4 * lane + 256 * j;
        const f32x4 g = *(const f32x4*)(gain + c), sh = *(const f32x4*)(shift + c), sc = *(const f32x4*)(scale + c);
        h[j] = (v[j] * rstd) * g * (sc + 1.f) + sh;
        v2u o; o.x = pk2(h[j].x, h[j].y); o.y = pk2(h[j].z, h[j].w);
        *(v2u*)(hrow + c) = o; }
}
template <bool SRCF32> __device__ __forceinline__ void row_load(const void* src_ctx, const void* src_lat, int row, int lane, f32x4 (&v)[4]) {
    const size_t off = row < NCTX ? (size_t)row * D : (size_t)(row - NCTX) * D; const void* base = row < NCTX ? src_ctx : src_lat;
#pragma unroll
    for (int j = 0; j < 4; ++j) { const int c = 4 * lane + 256 * j;
        if constexpr (SRCF32) v[j] = *(const f32x4*)((const float*)base + off + c);
        else { const v2u w = *(const v2u*)((const bf16*)base + off + c); v[j] = (f32x4){__uint_as_float(w.x << 16), __uint_as_float(w.x & 0xffff0000u), __uint_as_float(w.y << 16), __uint_as_float(w.y & 0xffff0000u)}; } }
}
__device__ __forceinline__ void row_store_xs(bf16* XS, int row, int c, const f32x4 v) { *(v2u*)(XS + (size_t)row * D + c) = (v2u){pg8::cvt_pk_bf16(v.x, v.y), pg8::cvt_pk_bf16(v.z, v.w)}; }
__device__ __forceinline__ int row_mrow(int row) { return row < NCTX ? 16 : ((row - NCTX) >> 11); }

template <int COMB  , bool SRCF32 = false>
__device__ __forceinline__ void norm_phase(const Args& a, const void* src_ctx, const void* src_lat, const float* gain, const float* mods_l, int m_shift, int m_scale,
                                           const float* mods_prev, int row_lo, int row_hi, int G) {
    const int tid = threadIdx.x, lane = tid & 63, wave = tid >> 6;
    const int gw = blockIdx.x * NWAVES + wave, NGW = G * NWAVES;
    bf16* H = (bf16*)(a.ws + WS_H); bf16* XS = (bf16*)(a.ws + WS_XS);
    const bf16* YS = (const bf16*)(a.ws + WS_YS); const unsigned* route = (const unsigned*)(a.ws + WS_ROUTE);
    constexpr int NR = 4;
    for (int row0 = row_lo + gw; row0 < row_hi; row0 += NR * NGW) {
        int rows[NR]; bool has[NR]; f32x4 v[NR][4], h[4];
#pragma unroll
        for (int r = 0; r < NR; ++r) { has[r] = row0 + r * NGW < row_hi; rows[r] = has[r] ? row0 + r * NGW : row0; }
#pragma unroll
        for (int r = 0; r < NR; ++r) row_load<SRCF32>(src_ctx, src_lat, rows[r], lane, v[r]);
        if (COMB == 3) { const bf16* DBa = (const bf16*)(a.ws + WS_DB2); const bf16* DBb = (const bf16*)(a.ws + WS_DB2B);
#pragma unroll
            for (int r = 0; r < NR; ++r) if (has[r] && rows[r] < NCTX) {
#pragma unroll
                for (int j = 0; j < 4; ++j) { const int c = 4 * lane + 256 * j; const v2u y0 = *(const v2u*)(DBa + (size_t)rows[r] * D + c), y1 = *(const v2u*)(DBb + (size_t)rows[r] * D + c);
                    v[r][j].x += bf2f(y0.x & 0xffffu) + bf2f(y1.x & 0xffffu); v[r][j].y += bf2f(y0.x >> 16) + bf2f(y1.x >> 16); v[r][j].z += bf2f(y0.y & 0xffffu) + bf2f(y1.y & 0xffffu); v[r][j].w += bf2f(y0.y >> 16) + bf2f(y1.y >> 16);
                    row_store_xs(XS, rows[r], c, v[r][j]); } }
        }
        if (COMB == 1) {
            unsigned s0[NR], s1[NR]; v2u y0[NR][4], y1[NR][4];
#pragma unroll
            for (int r = 0; r < NR; ++r) { s0[r] = route[(size_t)rows[r] * 8 + 6]; s1[r] = route[(size_t)rows[r] * 8 + 7]; }
#pragma unroll
            for (int r = 0; r < NR; ++r)
#pragma unroll
                for (int j = 0; j < 4; ++j) { const int c = 4 * lane + 256 * j; y0[r][j] = *(const v2u*)(YS + (size_t)s0[r] * D + c); y1[r][j] = *(const v2u*)(YS + (size_t)s1[r] * D + c); }
#pragma unroll
            for (int r = 0; r < NR; ++r) { const float* g5 = mods_prev + row_mrow(rows[r]) * MODW + 5 * D;
#pragma unroll
                for (int j = 0; j < 4; ++j) { const int c = 4 * lane + 256 * j; const f32x4 gg = *(const f32x4*)(g5 + c); const v2u ya = y0[r][j], yb = y1[r][j];
                    v[r][j].x += gg.x * (bf2f(ya.x & 0xffffu) + bf2f(yb.x & 0xffffu)); v[r][j].y += gg.y * (bf2f(ya.x >> 16) + bf2f(yb.x >> 16));
                    v[r][j].z += gg.z * (bf2f(ya.y & 0xffffu) + bf2f(yb.y & 0xffffu)); v[r][j].w += gg.w * (bf2f(ya.y >> 16) + bf2f(yb.y >> 16));
                    if (has[r]) row_store_xs(XS, rows[r], c, v[r][j]); } }
        }
#pragma unroll
        for (int r = 0; r < NR; ++r) if (has[r]) { const int mr = row_mrow(rows[r]);
            row_modnorm_store(v[r], gain, mods_l + mr * MODW + m_shift * D, mods_l + mr * MODW + m_scale * D, H + (size_t)rows[r] * D, lane, h); }
    }
}

__device__ __forceinline__ void norm_route_phase(const Args& a, const float* gain, const float* mods_l, const float* router, unsigned* cnt, int row_lo, int row_hi, unsigned char* lds, int G) {
    const int tid = threadIdx.x, lane = tid & 63, wave = tid >> 6;
    const int gw = blockIdx.x * NWAVES + wave, NGW = G * NWAVES;
    bf16* H = (bf16*)(a.ws + WS_H); const bf16* XS = (const bf16*)(a.ws + WS_XS); unsigned* route = (unsigned*)(a.ws + WS_ROUTE);
    LAS unsigned* lcnt = (LAS unsigned*)((LAS unsigned char*)lds + 32768);
    LAS float* rt = (LAS float*)lds;
    for (int i = tid; i < 1024 * 8; i += NTHR) { const int c = i >> 3, e = i & 7; rt[(e >> 2) * 4096 + (((c >> 8) * 4 + (c & 3)) * 64 + ((c & 255) >> 2)) * 4 + (e & 3)] = router[i]; }
    if (tid < 16) lcnt[tid] = 0u;
    __syncthreads();
    constexpr int NR = 4;
    for (int row0 = row_lo + gw; row0 < row_hi; row0 += NR * NGW) {
        int rows[NR]; bool has[NR]; f32x4 vv[NR][4];
#pragma unroll
        for (int r = 0; r < NR; ++r) { has[r] = row0 + r * NGW < row_hi; rows[r] = has[r] ? row0 + r * NGW : row0; }
#pragma unroll
        for (int r = 0; r < NR; ++r) row_load<false>(XS, XS + (size_t)NCTX * D, rows[r], lane, vv[r]);
#pragma unroll
        for (int r = 0; r < NR; ++r) if (has[r]) { const int row = rows[r];
            const int mr = row_mrow(row);
            f32x4 h[4];
            row_modnorm_store(vv[r], gain, mods_l + mr * MODW + 3 * D, mods_l + mr * MODW + 4 * D, H + (size_t)row * D, lane, h);
            float lg[8];
#pragma unroll
            for (int e = 0; e < 8; ++e) lg[e] = 0.f;
#pragma unroll
            for (int j = 0; j < 4; ++j)
#pragma unroll
                for (int i = 0; i < 4; ++i) { const f32x4 r0 = *(const LAS f32x4*)(rt + ((j * 4 + i) * 64 + lane) * 4), r1 = *(const LAS f32x4*)(rt + 4096 + ((j * 4 + i) * 64 + lane) * 4); const float hv = h[j][i];
                    lg[0] += hv * r0.x; lg[1] += hv * r0.y; lg[2] += hv * r0.z; lg[3] += hv * r0.w; lg[4] += hv * r1.x; lg[5] += hv * r1.y; lg[6] += hv * r1.z; lg[7] += hv * r1.w; }
#pragma unroll
            for (int e = 0; e < 8; ++e) lg[e] = wave_sum(lg[e]);
            int e0 = 0; float l0 = lg[0];
#pragma unroll
            for (int e = 1; e < 8; ++e) if (lg[e] > l0) { l0 = lg[e]; e0 = e; }
            int e1 = -1; float l1 = -3.0e38f;
#pragma unroll
            for (int e = 0; e < 8; ++e) if (e != e0 && lg[e] > l1) { l1 = lg[e]; e1 = e; }
            if (lane == 0) {
                const float g0 = 1.f / (1.f + __expf(l1 - l0)), g1 = 1.f - g0;
                const unsigned p0 = __hip_atomic_fetch_add(&lcnt[e0], 1u, __ATOMIC_RELAXED, __HIP_MEMORY_SCOPE_WORKGROUP), p1 = __hip_atomic_fetch_add(&lcnt[e1], 1u, __ATOMIC_RELAXED, __HIP_MEMORY_SCOPE_WORKGROUP);
                unsigned* rr = route + (size_t)row * 8;
                rr[0] = (unsigned)e0; rr[1] = (unsigned)e1; rr[2] = p0; rr[3] = p1; rr[4] = __float_as_uint(g0); rr[5] = __float_as_uint(g1);
            }
        }
    }
    __syncthreads();
    if (tid < 8) lcnt[8 + tid] = atomicAdd(cnt + tid * 64, lcnt[tid]);
    __syncthreads();
    for (int row = row_lo + gw; row < row_hi; row += NGW) {
        if (lane == 0) { unsigned* r = route + (size_t)row * 8; r[2] += lcnt[8 + r[0]]; r[3] += lcnt[8 + r[1]]; }
    }
}

__device__ __forceinline__ void moe_ranges(const unsigned* cnt, LAS unsigned* tab) {
    if (threadIdx.x == 0) { unsigned s = 0;
        for (int e = 0; e < 8; ++e) { const unsigned c = __hip_atomic_load(cnt + e * 64, __ATOMIC_RELAXED, __HIP_MEMORY_SCOPE_AGENT); tab[e] = s; tab[16 + e] = c; s += (c + 255u) & ~255u; tab[8 + e] = s; } }
    __syncthreads();
}

__device__ __forceinline__ void moe_fill_list(LAS int* list, int nwg, int G, int c, int nd) {
    const int i = threadIdx.x;
    if (i < 64) { long Lx;
        if (nd == 0) Lx = (long)i * G + c;
        else if (c < nd) Lx = (long)(i + 1) * G + c;
        else { const int r = (nwg - c + G - 1) / G;
            if (i < r) Lx = (long)i * G + c; else { const long j = (long)(c - nd) + (long)(i - r) * (G - nd); Lx = j < nd ? j : nwg; } }
        list[i] = Lx < nwg ? (int)Lx : nwg; }
}

__device__ __forceinline__ void gather_phase(const Args& a, const unsigned* cnt, int row_lo, int row_hi, unsigned char* lds, int G) {
    const int tid = threadIdx.x, lane = tid & 63, wave = tid >> 6;
    const int gw = blockIdx.x * NWAVES + wave, NGW = G * NWAVES;
    LAS unsigned* tab = (LAS unsigned*)lds;
    moe_ranges(cnt, tab);
    const bf16* H = (const bf16*)(a.ws + WS_H); bf16* XG = (bf16*)(a.ws + WS_XG); float* slotg = (float*)(a.ws + WS_SLOTG); unsigned* route = (unsigned*)(a.ws + WS_ROUTE);
    constexpr int NR = 4;
    for (int row0 = row_lo + gw; row0 < row_hi; row0 += NR * NGW) {
        int rows[NR]; bool has[NR]; v4u q[NR], x0[NR], x1[NR]; v2u g[NR];
#pragma unroll
        for (int r = 0; r < NR; ++r) { has[r] = row0 + r * NGW < row_hi; rows[r] = has[r] ? row0 + r * NGW : row0; }
#pragma unroll
        for (int r = 0; r < NR; ++r) { const unsigned* rr = route + (size_t)rows[r] * 8; q[r] = *(const v4u*)rr; g[r] = *(const v2u*)(rr + 4);
            const v4u* s = (const v4u*)(H + (size_t)rows[r] * D); x0[r] = s[lane]; x1[r] = s[64 + lane]; }
#pragma unroll
        for (int r = 0; r < NR; ++r) if (has[r]) { unsigned* rr = route + (size_t)rows[r] * 8;
            const unsigned s0 = tab[q[r].x] + q[r].z, s1 = tab[q[r].y] + q[r].w;
            if (lane == 0) { rr[6] = s0; rr[7] = s1; slotg[s0] = __uint_as_float(g[r].x); slotg[s1] = __uint_as_float(g[r].y); }
            v4u* d0 = (v4u*)(XG + (size_t)s0 * D); v4u* d1 = (v4u*)(XG + (size_t)s1 * D); d0[lane] = x0[r]; d0[64 + lane] = x1[r]; d1[lane] = x0[r]; d1[64 + lane] = x1[r]; }
    }
    for (int e = 0; e < 8; ++e) {
        const unsigned p0 = tab[e] + tab[16 + e], p1 = tab[8 + e];
        for (unsigned s = p0 + gw; s < p1; s += NGW) { v4u* d = (v4u*)(XG + (size_t)s * D); d[lane] = (v4u){0u, 0u, 0u, 0u}; d[64 + lane] = (v4u){0u, 0u, 0u, 0u}; if (lane == 0) slotg[s] = 0.f; }
    }
}

__device__ __forceinline__ float p_shift(const bf16* P, int row, int t, int Tlen, int pcol, float mu) {
    const float pc = bf2f(P[(size_t)row * DINP + pcol]);
    const float pm = t > 0 ? bf2f(P[(size_t)(row - 1) * DINP + pcol]) : 0.f;
    const float pn = t < Tlen - 1 ? bf2f(P[(size_t)(row + 1) * DINP + pcol]) : 0.f;
    return pc + mu * (0.5f * (pm + pn) - pc);
}

template <int CTRL> __device__ __forceinline__ float dpp_f(float x) { return __int_as_float(__builtin_amdgcn_update_dpp(0, __float_as_int(x), CTRL, 0xF, 0xF, true)); }
__device__ __forceinline__ float red16(float x) {
    x += dpp_f<0xB1>(x);
    x += dpp_f<0x4E>(x);
    x += dpp_f<0x141>(x);
    x += dpp_f<0x140>(x);
    return x;
}
__device__ __forceinline__ float fast_tanh(float x) { return 1.f - 2.f * __builtin_amdgcn_rcpf(1.f + __expf(2.f * x)); }

__device__ __forceinline__ pg8::bf16x8 frag4(const LAS bf16* p) { const v2u x = *(const LAS v2u*)p; return __builtin_bit_cast(pg8::bf16x8, (v4u){x.x, x.y, 0u, 0u}); }
__device__ __forceinline__ pg8::bf16x8 frag44(const LAS bf16* p, const LAS bf16* q) { const v2u x = *(const LAS v2u*)p, y = *(const LAS v2u*)q; return __builtin_bit_cast(pg8::bf16x8, (v4u){x.x, x.y, y.x, y.y}); }
__device__ __forceinline__ pg8::bf16x8 pack4(const f32x4 a) { return __builtin_bit_cast(pg8::bf16x8, (v4u){pg8::cvt_pk_bf16(a[0], a[1]), pg8::cvt_pk_bf16(a[2], a[3]), 0u, 0u}); }
__device__ __forceinline__ pg8::bf16x8 pack44(const f32x4 a, const f32x4 b) { return __builtin_bit_cast(pg8::bf16x8, (v4u){pg8::cvt_pk_bf16(a[0], a[1]), pg8::cvt_pk_bf16(a[2], a[3]), pg8::cvt_pk_bf16(b[0], b[1]), pg8::cvt_pk_bf16(b[2], b[3])}); }
__device__ __forceinline__ void shift8r(const v4u xc, const v4u xm, const v4u xn, const LAS float* mu8, f32x4& u0, f32x4& u1) {
    const f32x4 m0 = *(const LAS f32x4*)(mu8), m1 = *(const LAS f32x4*)(mu8 + 4);
#define S8_ONE(dst, k_, wsel, mm) { const float pc_ = bf2f(xc.wsel & 0xffffu), pm_ = bf2f(xm.wsel & 0xffffu), pn_ = bf2f(xn.wsel & 0xffffu); dst[k_] = pc_ + mm[k_] * ((pm_ + pn_) * 0.5f - pc_); \
      const float qc_ = __uint_as_float(xc.wsel & 0xffff0000u), qm_ = __uint_as_float(xm.wsel & 0xffff0000u), qn_ = __uint_as_float(xn.wsel & 0xffff0000u); dst[k_ + 1] = qc_ + mm[k_ + 1] * ((qm_ + qn_) * 0.5f - qc_); }
    S8_ONE(u0, 0, x, m0) S8_ONE(u0, 2, y, m0) S8_ONE(u1, 0, z, m1) S8_ONE(u1, 2, w, m1)
#undef S8_ONE
}

__device__ __forceinline__ bf16 hw_bf16(float x) { return (bf16)(pg8::cvt_pk_bf16(x, x) & 0xffffu); }
__device__ __forceinline__ void scan_phase(const Args& a, int l, bool last, unsigned char* lds, int G) {
    typedef pg8::bf16x8 bf16x8;
    const int tid = threadIdx.x;
    const bf16* P = (const bf16*)(a.ws + WS_P); float* YD = (float*)(a.ws + WS_YD); float* SB = (float*)(a.ws + WS_SB);
    LAS unsigned char* L = (LAS unsigned char*)lds;
    LAS bf16* W2b = (LAS bf16*)(L);
    LAS bf16* A2b = (LAS bf16*)(L + 9216);
    LAS float* vec = (LAS float*)(L + 18432);
    LAS float* w0s = vec, *a0s = vec + 64, *kks = vec + 128, *kas = vec + 192, *rks = vec + 256, *mus = vec + 320;
    LAS float* Zs = (LAS float*)(L + 21248);
    volatile LAS int* done = (volatile LAS int*)(L + 37632);
    LAS v4u* SF = (LAS v4u*)(L + 121664);
    for (int chain = blockIdx.x; chain < 256; chain += G) {
        const int b = chain >> 4, h = (chain >> 1) & 7, d = chain & 1;
        __syncthreads();
        {
            static_assert(NTHR == 512, "the chain set-up assumes 512 threads");
            float w2v[8], a2v[8], v5[5], muv, sfm[3];
#pragma unroll
            for (int j = 0; j < 8; ++j) { const int i = tid + NTHR * j, r = i >> 6, c = i & 63;
                w2v[j] = a.in[I_W2][(((size_t)l * 2 + d) * 64 + r) * DRW + h * 64 + c]; a2v[j] = a.in[I_A2][(((size_t)l * 2 + d) * 64 + r) * DRW + h * 64 + c]; }
            { const int c = h * 64 + (tid & 63);
                v5[0] = a.in[I_W0][(l * 2 + d) * DRW + c]; v5[1] = a.in[I_A0][(l * 2 + d) * DRW + c]; v5[2] = a.in[I_KK][l * DRW + c]; v5[3] = a.in[I_KA][l * DRW + c]; v5[4] = a.in[I_RK][l * DRW + c]; }
            { const int j = tid < 320 ? tid : 0; const int ucol = j < 64 ? h * 64 + j : j < 128 ? 512 + h * 64 + (j - 64) : j < 192 ? 1024 + h * 64 + (j - 128) : j < 256 ? 1536 + d * 64 + (j - 192) : 1664 + d * 64 + (j - 256);
                muv = a.in[I_MU][l * DSHIFT + ucol]; }
#pragma unroll
            for (int j = 0; j < 3; ++j) { const int i = tid + NTHR * j, f = i >> 6, ln = i & 63, arr = f >> 3, nt = (f >> 1) & 3, fr_ = ln & 15; sfm[j] = a.in[I_MU][l * DSHIFT + arr * 512 + h * 64 + 16 * nt + fr_]; }
#pragma unroll
            for (int j = 0; j < 8; ++j) { const int i = tid + NTHR * j, r = i >> 6, c = i & 63; W2b[c * 72 + r] = (bf16)f2bf(w2v[j]); A2b[c * 72 + r] = (bf16)f2bf(a2v[j]); }
            if (tid < 64) { w0s[tid] = v5[0]; a0s[tid] = v5[1]; kks[tid] = v5[2]; kas[tid] = v5[3]; rks[tid] = v5[4]; }
            if (tid < 320) mus[tid] = muv;
            for (int i = tid; i < 4096; i += NTHR) Zs[i] = 0.f;
#pragma unroll
            for (int j = 0; j < 3; ++j) { const int i = tid + NTHR * j, f = i >> 6, ln = i & 63, nt = (f >> 1) & 3, kind = f & 1, fr_ = ln & 15, fq_ = ln >> 4;
                const unsigned hb = (fq_ == 2 * (nt & 1) + (fr_ >> 3)) ? f2bf(kind ? 0.5f * sfm[j] : 1.f - sfm[j]) << (16 * (fr_ & 1)) : 0u;
                const int ds = (fr_ & 7) >> 1;
                SF[i] = (v4u){ds == 0 ? hb : 0u, ds == 1 ? hb : 0u, ds == 2 ? hb : 0u, ds == 3 ? hb : 0u}; }
        }
        if (tid == 0) *done = 0;
        __syncthreads();
        const int wv = __builtin_amdgcn_readfirstlane(tid >> 6);
        LAS unsigned char* Wp = L + 37696 + wv * 10496;
        LAS bf16* X = (LAS bf16*)Wp;
        LAS bf16* Qt = X, *Rt = X + 1152, *Kt = X + 2304, *Bt = X + 3456;
        LAS bf16* Tm = X + 2304, *Ak = Tm + 384, *Gk = Ak + 384, *Gb = Gk + 384;
        LAS float* Ab = (LAS float*)(Wp + 9216);
        LAS float* gCs = (LAS float*)(Wp + 10240);
        for (int n = wv; n < 144; n += 8) {
            int lane = tid & 63; asm volatile("" : "+v"(lane));
            const int fr = lane & 15, fq = lane >> 4;
            const bool isctx = n < 16; const int Tlen = isctx ? CTXL : SEQ, rowbase = isctx ? b * CTXL : NCTX + b * SEQ, cn = isctx ? n : n - 16;
#define T_OF(i_) (d ? Tlen - 1 - (16 * cn + (i_)) : 16 * cn + (i_))
            const int tA = T_OF(fr); const bool hm = tA > 0, hn = tA < Tlen - 1;
            const bf16* prow = P + (size_t)(rowbase + tA) * DINP + URW;
            const bf16* zrow = (const bf16*)(a.ws + WS_CTL + 512 * 1024);
            const bf16* prm = hm ? prow - DINP : zrow; const bf16* prn = hn ? prow + DINP : zrow;
            v4u lw[2][3], la[2][3], xr[3][2][3];
#pragma unroll
            for (int ks = 0; ks < 2; ++ks) { const int cw = 1536 + d * 64 + 32 * ks + 8 * fq, ca = 1664 + d * 64 + 32 * ks + 8 * fq;
                lw[ks][0] = *(const v4u*)(prow + cw); lw[ks][1] = *(const v4u*)(prm + cw); lw[ks][2] = *(const v4u*)(prn + cw);
                la[ks][0] = *(const v4u*)(prow + ca); la[ks][1] = *(const v4u*)(prm + ca); la[ks][2] = *(const v4u*)(prn + ca); }
#pragma unroll
            for (int arr = 0; arr < 3; ++arr)
#pragma unroll
                for (int ks = 0; ks < 2; ++ks) { const int co = arr * 512 + h * 64 + 32 * ks + 8 * fq;
                    xr[arr][ks][0] = *(const v4u*)(prow + co); xr[arr][ks][1] = *(const v4u*)(prm + co); xr[arr][ks][2] = *(const v4u*)(prn + co); }
            bf16x8 fa_w[2], fa_a[2];
#pragma unroll
            for (int ks = 0; ks < 2; ++ks) { f32x4 u0, u1;
                shift8r(lw[ks][0], lw[ks][1], lw[ks][2], mus + 192 + 32 * ks + 8 * fq, u0, u1);
                fa_w[ks] = __builtin_bit_cast(bf16x8, (v4u){pg8::cvt_pk_bf16(fast_tanh(u0[0]), fast_tanh(u0[1])), pg8::cvt_pk_bf16(fast_tanh(u0[2]), fast_tanh(u0[3])), pg8::cvt_pk_bf16(fast_tanh(u1[0]), fast_tanh(u1[1])), pg8::cvt_pk_bf16(fast_tanh(u1[2]), fast_tanh(u1[3]))});
                shift8r(la[ks][0], la[ks][1], la[ks][2], mus + 256 + 32 * ks + 8 * fq, u0, u1);
                fa_a[ks] = __builtin_bit_cast(bf16x8, (v4u){pg8::cvt_pk_bf16(u0[0], u0[1]), pg8::cvt_pk_bf16(u0[2], u0[3]), pg8::cvt_pk_bf16(u1[0], u1[1]), pg8::cvt_pk_bf16(u1[2], u1[3])}); }
            f32x4 rrv[4], kxv[4], vvv[4];
#define SHIFT_ARR(arr_, dst_) \
            _Pragma("unroll") for (int ks = 0; ks < 2; ++ks) { \
                const bf16x8 fc = __builtin_bit_cast(bf16x8, xr[arr_][ks][0]), fm = __builtin_bit_cast(bf16x8, xr[arr_][ks][1]), fn = __builtin_bit_cast(bf16x8, xr[arr_][ks][2]); \
                _Pragma("unroll") for (int q = 0; q < 2; ++q) { const int nt = 2 * ks + q; \
                    const bf16x8 bc = __builtin_bit_cast(bf16x8, SF[(((arr_) * 4 + nt) * 2 + 0) * 64 + lane]), bn = __builtin_bit_cast(bf16x8, SF[(((arr_) * 4 + nt) * 2 + 1) * 64 + lane]); \
                    f32x4 acc = {0.f, 0.f, 0.f, 0.f}; \
                    acc = __builtin_amdgcn_mfma_f32_16x16x32_bf16(fc, bc, acc, 0, 0, 0); acc = __builtin_amdgcn_mfma_f32_16x16x32_bf16(fm, bn, acc, 0, 0, 0); acc = __builtin_amdgcn_mfma_f32_16x16x32_bf16(fn, bn, acc, 0, 0, 0); \
                    dst_[nt] = acc; } }
            SHIFT_ARR(0, rrv) SHIFT_ARR(1, kxv) SHIFT_ARR(2, vvv)
#undef SHIFT_ARR
            f32x4 accw[4], acca[4];
#pragma unroll
            for (int nt = 0; nt < 4; ++nt) { accw[nt] = (f32x4){0.f, 0.f, 0.f, 0.f}; acca[nt] = (f32x4){0.f, 0.f, 0.f, 0.f};
#pragma unroll
                for (int ks = 0; ks < 2; ++ks) {
                    accw[nt] = __builtin_amdgcn_mfma_f32_16x16x32_bf16(fa_w[ks], *(const LAS bf16x8*)(W2b + (16 * nt + fr) * 72 + 32 * ks + 8 * fq), accw[nt], 0, 0, 0);
                    acca[nt] = __builtin_amdgcn_mfma_f32_16x16x32_bf16(fa_a[ks], *(const LAS bf16x8*)(A2b + (16 * nt + fr) * 72 + 32 * ks + 8 * fq), acca[nt], 0, 0, 0); } }
            f32x4 kkv[4], bbv[4], kdv[4], cu[4];
            float n2[4] = {0.f, 0.f, 0.f, 0.f}, sb[4] = {0.f, 0.f, 0.f, 0.f};
#pragma unroll
            for (int nt = 0; nt < 4; ++nt) { const int c = 16 * nt + fr; const float w0c = w0s[c], a0c = a0s[c], kkc = kks[c], kac = kas[c], rkc = rks[c];
#pragma unroll
                for (int e = 0; e < 4; ++e) {
                    const float rr = rrv[nt][e], kx = kxv[nt][e];
                    const float ew = 0.60653065971f * sigmoidf_(w0c + accw[nt][e]);
                    const float av = sigmoidf_(a0c + acca[nt][e]);
                    const float kraw = kx * kkc, kd = kx * (1.f + (av - 1.f) * kac);
                    n2[e] += kraw * kraw; sb[e] += rr * kd * rkc;
                    kkv[nt][e] = kraw; bbv[nt][e] = av; kdv[nt][e] = kd; cu[nt][e] = ew; } }
            float inv[4];
#pragma unroll
            for (int e = 0; e < 4; ++e) { inv[e] = __builtin_amdgcn_rsqf(fmaxf(red16(n2[e]), 1e-24f)); sb[e] = red16(sb[e]); }
            f32x4 qv[4], rv[4], kv[4], bv[4], khv[4], bhv[4];
#pragma unroll
            for (int nt = 0; nt < 4; ++nt) {
                const float p0 = cu[nt][0], p1 = p0 + cu[nt][1], p2 = p1 + cu[nt][2], p3 = p2 + cu[nt][3];
                float t1 = __shfl_up(p3, 16); if (fq < 1) t1 = 0.f; const float s1 = p3 + t1;
                float t2 = __shfl_up(s1, 32); if (fq < 2) t2 = 0.f; const float incl = s1 + t2, excl = incl - p3;
                const float cC = __shfl(incl, 48 + fr);
                const float cuv[4] = {excl + p0, excl + p1, excl + p2, excl + p3}, cpv[4] = {excl, excl + p0, excl + p1, excl + p2};
                const float gCv = __expf(-cC);
                float enp = __expf(-excl);
                (void)cpv;
#pragma unroll
                for (int e = 0; e < 4; ++e) { const float kk = kkv[nt][e] * inv[e], bb = kk * bbv[nt][e];
                    const float eu = __expf(cuv[e]), en = __builtin_amdgcn_rcpf(eu), ep = enp, eh = eu * gCv;
                    enp = en;
                    qv[nt][e] = kk * ep; rv[nt][e] = rrv[nt][e] * en; kv[nt][e] = kdv[nt][e] * eu; bv[nt][e] = bb * eu; khv[nt][e] = kdv[nt][e] * eh; bhv[nt][e] = -bb * eh; }
                if (fq == 3) gCs[16 * nt + fr] = gCv;
            }
#pragma unroll
            for (int nt = 0; nt < 4; ++nt)
#pragma unroll
                for (int e = 0; e < 4; ++e) { const int o = (4 * fq + e) * 72 + 16 * nt + fr;
                    Qt[o] = hw_bf16(qv[nt][e]); Rt[o] = hw_bf16(rv[nt][e]); Kt[o] = hw_bf16(kv[nt][e]); Bt[o] = hw_bf16(bv[nt][e]); }
            f32x4 m4[4], abt;
            { const LAS bf16* pq = Qt + fr * 72 + 8 * fq; const LAS bf16* pr = Rt + fr * 72 + 8 * fq; const LAS bf16* pk = Kt + fr * 72 + 8 * fq; const LAS bf16* pb = Bt + fr * 72 + 8 * fq;
                const bf16x8 q0 = *(const LAS bf16x8*)pq, q1 = *(const LAS bf16x8*)(pq + 32), r0f = *(const LAS bf16x8*)pr, r1f = *(const LAS bf16x8*)(pr + 32);
                const bf16x8 k0 = *(const LAS bf16x8*)pk, k1 = *(const LAS bf16x8*)(pk + 32), b0 = *(const LAS bf16x8*)pb, b1 = *(const LAS bf16x8*)(pb + 32);
                const f32x4 zero = {0.f, 0.f, 0.f, 0.f};
                m4[0] = __builtin_amdgcn_mfma_f32_16x16x32_bf16(q1, b1, __builtin_amdgcn_mfma_f32_16x16x32_bf16(q0, b0, zero, 0, 0, 0), 0, 0, 0);
                abt   = __builtin_amdgcn_mfma_f32_16x16x32_bf16(b1, q1, __builtin_amdgcn_mfma_f32_16x16x32_bf16(b0, q0, zero, 0, 0, 0), 0, 0, 0);
                m4[1] = __builtin_amdgcn_mfma_f32_16x16x32_bf16(q1, k1, __builtin_amdgcn_mfma_f32_16x16x32_bf16(q0, k0, zero, 0, 0, 0), 0, 0, 0);
                m4[2] = __builtin_amdgcn_mfma_f32_16x16x32_bf16(r1f, k1, __builtin_amdgcn_mfma_f32_16x16x32_bf16(r0f, k0, zero, 0, 0, 0), 0, 0, 0);
                m4[3] = __builtin_amdgcn_mfma_f32_16x16x32_bf16(r1f, b1, __builtin_amdgcn_mfma_f32_16x16x32_bf16(r0f, b0, zero, 0, 0, 0), 0, 0, 0); }
            f32x4 nn, nt, idv;
#pragma unroll
            for (int e = 0; e < 4; ++e) { const int t = 4 * fq + e;
                m4[1][e] = (fr < t) ? m4[1][e] : 0.f; m4[2][e] = (fr <= t) ? m4[2][e] : 0.f; m4[3][e] = (fr <= t) ? m4[3][e] : 0.f;
                nn[e] = (fr < t) ? -m4[0][e] : 0.f; nt[e] = (t < fr) ? -abt[e] : 0.f; idv[e] = (t == fr) ? 1.f : 0.f; }
#pragma unroll
            for (int e = 0; e < 4; ++e) { const int t = 4 * fq + e; Ak[t * 24 + fr] = hw_bf16(m4[1][e]); Gk[t * 24 + fr] = hw_bf16(m4[2][e]); Gb[t * 24 + fr] = hw_bf16(-m4[3][e]); }
            bf16x8 TF;
            { const f32x4 zero = {0.f, 0.f, 0.f, 0.f};
                const bf16x8 pn = pack4(nn), pnt = pack4(nt);
                const f32x4 n2 = __builtin_amdgcn_mfma_f32_16x16x32_bf16(pnt, pn, zero, 0, 0, 0), n2t = __builtin_amdgcn_mfma_f32_16x16x32_bf16(pn, pnt, zero, 0, 0, 0);
                const bf16x8 p2 = pack4(n2), p2t = pack4(n2t);
                const f32x4 n4 = __builtin_amdgcn_mfma_f32_16x16x32_bf16(p2t, p2, zero, 0, 0, 0), n4t = __builtin_amdgcn_mfma_f32_16x16x32_bf16(p2, p2t, zero, 0, 0, 0);
                const f32x4 n8t = __builtin_amdgcn_mfma_f32_16x16x32_bf16(pack4(n4), pack4(n4t), zero, 0, 0, 0);
                const f32x4 ra = __builtin_amdgcn_mfma_f32_16x16x32_bf16(pack4(n4 + idv), pack4(n8t + idv), zero, 0, 0, 0);
                const f32x4 rb2 = __builtin_amdgcn_mfma_f32_16x16x32_bf16(pack4(n2 + idv), pack4(ra), zero, 0, 0, 0);
                const f32x4 tt = __builtin_amdgcn_mfma_f32_16x16x32_bf16(pack4(nn + idv), pack4(rb2), zero, 0, 0, 0);
                TF = pack4(tt); }
            bf16x8 Vb[4], KBF[4];
#pragma unroll
            for (int nt = 0; nt < 4; ++nt) { Vb[nt] = pack4(vvv[nt]); KBF[nt] = pack44(khv[nt], bhv[nt]); }
            const bf16x8 AkF = frag4(Ak + fr * 24 + 4 * fq), GkbF = frag44(Gk + fr * 24 + 4 * fq, Gb + fr * 24 + 4 * fq);
            f32x4 AkV[4];
            { const f32x4 zero = {0.f, 0.f, 0.f, 0.f};
#pragma unroll
                for (int sl = 0; sl < 4; ++sl) AkV[sl] = __builtin_amdgcn_mfma_f32_16x16x32_bf16(AkF, Vb[sl], zero, 0, 0, 0); }
            const bf16x8 Qf0 = frag44(Qt + fr * 72 + 4 * fq, Qt + fr * 72 + 16 + 4 * fq), Qf1 = frag44(Qt + fr * 72 + 32 + 4 * fq, Qt + fr * 72 + 48 + 4 * fq);
            const bf16x8 Rf0 = frag44(Rt + fr * 72 + 4 * fq, Rt + fr * 72 + 16 + 4 * fq), Rf1 = frag44(Rt + fr * 72 + 32 + 4 * fq, Rt + fr * 72 + 48 + 4 * fq);
            f32x4 g4[4];
#pragma unroll
            for (int zt = 0; zt < 4; ++zt) g4[zt] = *(const LAS f32x4*)(gCs + 16 * zt + 4 * fq);
#pragma unroll
            for (int zt = 0; zt < 4; ++zt) asm volatile("" : "+v"(KBF[zt]));
            while (*done != n) __builtin_amdgcn_s_sleep(1);
            asm volatile("" ::: "memory");
            f32x4 zacc[4][4]; bf16x8 zb0[4], zb1[4], ub[4];
#pragma unroll
            for (int sl = 0; sl < 4; ++sl) { f32x4 z[4];
#pragma unroll
                for (int zt = 0; zt < 4; ++zt) z[zt] = *(const LAS f32x4*)(Zs + ((zt * 4 + sl) * 64 + lane) * 4);
                zb0[sl] = pack44(z[0], z[1]); zb1[sl] = pack44(z[2], z[3]);
#pragma unroll
                for (int zt = 0; zt < 4; ++zt) zacc[zt][sl] = g4[zt] * z[zt]; }
            f32x4 Wv[4];
#pragma unroll
            for (int sl = 0; sl < 4; ++sl) Wv[sl] = __builtin_amdgcn_mfma_f32_16x16x32_bf16(Qf0, zb0[sl], AkV[sl], 0, 0, 0);
#pragma unroll
            for (int sl = 0; sl < 4; ++sl) Wv[sl] = __builtin_amdgcn_mfma_f32_16x16x32_bf16(Qf1, zb1[sl], Wv[sl], 0, 0, 0);
            { const f32x4 zero = {0.f, 0.f, 0.f, 0.f};
#pragma unroll
                for (int sl = 0; sl < 4; ++sl) Wv[sl] = __builtin_amdgcn_mfma_f32_16x16x32_bf16(TF, pack4(Wv[sl]), zero, 0, 0, 0); }
#pragma unroll
            for (int sl = 0; sl < 4; ++sl) { const v4u vb = __builtin_bit_cast(v4u, Vb[sl]); ub[sl] = __builtin_bit_cast(bf16x8, (v4u){vb.x, vb.y, pg8::cvt_pk_bf16(Wv[sl][0], Wv[sl][1]), pg8::cvt_pk_bf16(Wv[sl][2], Wv[sl][3])}); }
#pragma unroll
            for (int zt = 0; zt < 4; ++zt)
#pragma unroll
                for (int sl = 0; sl < 4; ++sl) *(LAS f32x4*)(Zs + ((zt * 4 + sl) * 64 + lane) * 4) = __builtin_amdgcn_mfma_f32_16x16x32_bf16(KBF[zt], ub[sl], zacc[zt][sl], 0, 0, 0);
            asm volatile("s_waitcnt lgkmcnt(0)" ::: "memory");
            if (lane == 0) *done = n + 1;
            f32x4 Yo[4];
#pragma unroll
            for (int sl = 0; sl < 4; ++sl) Yo[sl] = __builtin_amdgcn_mfma_f32_16x16x32_bf16(Rf0, zb0[sl], (f32x4){0.f, 0.f, 0.f, 0.f}, 0, 0, 0);
#pragma unroll
            for (int sl = 0; sl < 4; ++sl) Yo[sl] = __builtin_amdgcn_mfma_f32_16x16x32_bf16(Rf1, zb1[sl], Yo[sl], 0, 0, 0);
#pragma unroll
            for (int sl = 0; sl < 4; ++sl) Yo[sl] = __builtin_amdgcn_mfma_f32_16x16x32_bf16(GkbF, ub[sl], Yo[sl], 0, 0, 0);
            if (!(last && isctx)) {
#pragma unroll
                for (int e = 0; e < 4; ++e) { const int t = T_OF(4 * fq + e); bf16* yr = (bf16*)YD + ((size_t)d * NTOK + rowbase + t) * DRW + h * 64 + 4 * fr;
                    *(v2u*)yr = (v2u){pg8::cvt_pk_bf16(Yo[0][e], Yo[1][e]), pg8::cvt_pk_bf16(Yo[2][e], Yo[3][e])};
                    if (fr == 0) SB[((size_t)d * NTOK + rowbase + t) * 8 + h] = sb[e]; }
            }
#undef T_OF
        }
    }
}

__device__ __forceinline__ void readout_phase(const Args& a, int l, int row_lo, int row_hi, unsigned char* lds, int G) {
    typedef pg8::bf16x8 bf16x8;
    const int tid0 = threadIdx.x, wv = __builtin_amdgcn_readfirstlane(tid0 >> 6), h = wv;
    const bf16* P = (const bf16*)(a.ws + WS_P); const float* YD = (const float*)(a.ws + WS_YD); const float* SB = (const float*)(a.ws + WS_SB); bf16* YCAT = (bf16*)(a.ws + WS_YCAT);
    const bf16* g2t = (const bf16*)(a.ws + WS_G2T) + (size_t)l * DRW * 128; const bf16* YDb = (const bf16*)YD;
    LAS unsigned char* L = (LAS unsigned char*)lds;
    LAS bf16* Pg = (LAS bf16*)L;
    LAS bf16* Pv = (LAS bf16*)(L + 4896);
    LAS bf16* SGb = (LAS bf16*)(L + 4896 + 18720);
    LAS bf16* Ot = (LAS bf16*)(L + 4896 + 18720 + 4352);
    const float* mu = a.in[I_MU] + l * DSHIFT;
    bf16x8 bfr[4][4]; float lnw[4], lnb[4], muv[4];
    { const int lane = tid0 & 63, fr = lane & 15, fq = lane >> 4;
#pragma unroll
        for (int nt = 0; nt < 4; ++nt) { const int c = 64 * h + 16 * nt + fr; lnw[nt] = a.in[I_LNW][l * DRW + c]; lnb[nt] = a.in[I_LNB][l * DRW + c]; muv[nt] = mu[1024 + c];
#pragma unroll
            for (int ks = 0; ks < 4; ++ks) bfr[nt][ks] = *(const bf16x8*)(g2t + (size_t)c * 128 + 32 * ks + 8 * fq); } }
    const int nblk = (row_hi - row_lo) / 16;
    v4u xa[3];
#define RO_LOADA(blk_, tid_) { const int R0_ = row_lo + (blk_) * 16; const int t0_ = R0_ < NCTX ? (R0_ & 255) : ((R0_ - NCTX) & 2047), Tlen_ = R0_ < NCTX ? CTXL : SEQ; \
        _Pragma("unroll") for (int q = 0; q < 3; ++q) { const int pc = (tid_) + 512 * q; v4u x = {0u, 0u, 0u, 0u}; \
            if (pc < 1440 && (blk_) < nblk) { const int rr = pc / 80, sg = pc % 80, t = t0_ - 1 + rr; const int col = sg < 16 ? URW + 1792 + sg * 8 : URW + 1024 + (sg - 16) * 8; \
                if (t >= 0 && t < Tlen_) x = *(const v4u*)(P + (size_t)(R0_ - 1 + rr) * DINP + col); } \
            xa[q] = x; } }
    RO_LOADA((int)blockIdx.x, tid0)
    for (int blk = blockIdx.x; blk < nblk; blk += G) {
        int tid = tid0; asm volatile("" : "+v"(tid));
        const int lane = tid & 63, fr = lane & 15, fq = lane >> 4;
        const int R0 = row_lo + blk * 16;
        float ya[4][4], yb[4][4], sba[4], sbb[4];
#pragma unroll
        for (int e = 0; e < 4; ++e) { const int row = R0 + 4 * fq + e;
            { const v2u wa = *(const v2u*)(YDb + (size_t)row * DRW + 64 * h + 4 * fr), wb = *(const v2u*)(YDb + ((size_t)NTOK + row) * DRW + 64 * h + 4 * fr);
                ya[e][0] = bf2f(wa.x & 0xffffu); ya[e][1] = bf2f(wa.x >> 16); ya[e][2] = bf2f(wa.y & 0xffffu); ya[e][3] = bf2f(wa.y >> 16);
                yb[e][0] = bf2f(wb.x & 0xffffu); yb[e][1] = bf2f(wb.x >> 16); yb[e][2] = bf2f(wb.y & 0xffffu); yb[e][3] = bf2f(wb.y >> 16); }
            sba[e] = SB[(size_t)row * 8 + h]; sbb[e] = SB[((size_t)NTOK + row) * 8 + h]; }
        __syncthreads();
#pragma unroll
        for (int q = 0; q < 3; ++q) { const int pc = tid + 512 * q;
            if (pc < 1440) { const int rr = pc / 80, sg = pc % 80;
                if (sg < 16) *(LAS v4u*)(Pg + rr * 136 + sg * 8) = xa[q]; else *(LAS v4u*)(Pv + rr * 520 + (sg - 16) * 8) = xa[q]; } }
        RO_LOADA(blk + G, tid)
        __syncthreads();
        { const int i = tid >> 5, r4 = (tid & 31) * 4;
            const v2u wc = *(const LAS v2u*)(Pg + (i + 1) * 136 + r4), wm = *(const LAS v2u*)(Pg + i * 136 + r4), wn = *(const LAS v2u*)(Pg + (i + 2) * 136 + r4);
            const f32x4 m4 = *(const f32x4*)(mu + 1792 + r4);
            const f32x4 pc = {bf2f(wc.x & 0xffffu), bf2f(wc.x >> 16), bf2f(wc.y & 0xffffu), bf2f(wc.y >> 16)}, pm = {bf2f(wm.x & 0xffffu), bf2f(wm.x >> 16), bf2f(wm.y & 0xffffu), bf2f(wm.y >> 16)},
                        pn = {bf2f(wn.x & 0xffffu), bf2f(wn.x >> 16), bf2f(wn.y & 0xffffu), bf2f(wn.y >> 16)};
            const f32x4 u = pc + m4 * ((pm + pn) * 0.5f - pc);
            *(LAS v2u*)(SGb + i * 136 + r4) = (v2u){pg8::cvt_pk_bf16(sigmoidf_(u.x), sigmoidf_(u.y)), pg8::cvt_pk_bf16(sigmoidf_(u.z), sigmoidf_(u.w))}; }
        __syncthreads();
        f32x4 g[4];
#pragma unroll
        for (int nt = 0; nt < 4; ++nt) g[nt] = (f32x4){0.f, 0.f, 0.f, 0.f};
#pragma unroll
        for (int ks = 0; ks < 4; ++ks) { const bf16x8 af = *(const LAS bf16x8*)(SGb + fr * 136 + 32 * ks + 8 * fq);
#pragma unroll
            for (int nt = 0; nt < 4; ++nt) g[nt] = __builtin_amdgcn_mfma_f32_16x16x32_bf16(af, bfr[nt][ks], g[nt], 0, 0, 0); }
#pragma unroll
        for (int e = 0; e < 4; ++e) { const int i = 4 * fq + e;
            float y[4], s1 = 0.f;
#pragma unroll
            for (int nt = 0; nt < 4; ++nt) { y[nt] = ya[e][nt] + yb[e][nt]; s1 += y[nt]; }
            const float mean = red16(s1) * (1.f / 64.f); float s2 = 0.f;
#pragma unroll
            for (int nt = 0; nt < 4; ++nt) { y[nt] -= mean; s2 += y[nt] * y[nt]; }
            const float rstd = rsqrtf(red16(s2) * (1.f / 64.f) + GN_EPS);
            const float sbv = 0.5f * (sba[e] + sbb[e]);
#pragma unroll
            for (int nt = 0; nt < 4; ++nt) { const int c = 64 * h + 16 * nt + fr;
                const float pc = bf2f(Pv[(i + 1) * 520 + c]), pm = bf2f(Pv[i * 520 + c]), pn = bf2f(Pv[(i + 2) * 520 + c]);
                const float vs = pc + muv[nt] * (0.5f * (pm + pn) - pc);
                Ot[i * 520 + c] = (bf16)f2bf((y[nt] * rstd * lnw[nt] + lnb[nt] + sbv * vs) * g[nt][e]); } }
        __syncthreads();
#pragma unroll
        for (int q = 0; q < 2; ++q) { const int pc = tid + 512 * q, i = pc >> 6, sg = pc & 63;
            *(v4u*)(YCAT + (size_t)(R0 + i) * D + sg * 8) = *(const LAS v4u*)(Ot + i * 520 + sg * 8); }
    }
#undef RO_LOADA
}

template <bool LOCAL>
__device__ __forceinline__ void na_unit(const bf16* P, const bf16* VT, bf16* YCAT, const LAS float* rpb_l, LAS bf16* buf, int b, int gr, int hp, int qblk, int tid) {
    typedef pg8::bf16x8 bf16x8;
    constexpr int NCH = LOCAL ? 12 : 4, NLOC = LOCAL ? 8 : 0;
    const int lane = tid & 63, wv = tid >> 6, fr = lane & 15, fq = lane >> 4, hh = wv >> 2, qb = wv & 3, h = 2 * hp + hh;
    const int qrow0 = LOCAL ? NCTX + b * SEQ + gr * 64 + 16 * qb : b * CTXL + qblk * 64 + 16 * qb;
    const int r0 = min(max(gr - 4, 0), 24);
    const int kc0 = qb == 0 ? 0 : qb == 1 ? 8 : qb == 2 ? 24 : 32;
    const int qcol = 16 * qb + fr, cs = min(max(qcol - 8, 0), 48);
    const LAS float* rpb = rpb_l + h * 15 * 31;
    v4u ld[2][2];
    const int lrow = (tid >> 3) & 63, lseg = tid & 7;
#define NA_TOKBASE(c) ((LOCAL && (c) < 8) ? NCTX + b * SEQ + (r0 + (c)) * 64 : b * CTXL + ((c) - NLOC) * 64)
#define NA_ISSUE(sidx) do { const int c_ = (sidx) % NCH; const int tb_ = NA_TOKBASE(c_); _Pragma("unroll") for (int q_ = 0; q_ < 2; ++q_) { \
        if ((sidx) < NCH) ld[(sidx) & 1][q_] = *(const v4u*)(P + (size_t)(tb_ + lrow) * DINP + 512 + (2 * hp + q_) * 64 + lseg * 8); \
        else ld[(sidx) & 1][q_] = *(const v4u*)(VT + (size_t)((2 * hp + q_) * 64 + lrow) * NTOK + tb_ + lseg * 8); } } while (0)
#define NA_STORE(sidx) do { LAS bf16* d_ = buf + ((sidx) & 1) * 9216; _Pragma("unroll") for (int q_ = 0; q_ < 2; ++q_) *(LAS v4u*)(d_ + q_ * 4608 + lrow * 72 + lseg * 8) = ld[(sidx) & 1][q_]; } while (0)
    bf16x8 qf[2];
#pragma unroll
    for (int ks = 0; ks < 2; ++ks) qf[ks] = *(const bf16x8*)(P + (size_t)(qrow0 + fr) * DINP + h * 64 + 32 * ks + 8 * fq);
    f32x4 sl[16], sc[16];
    float m = -1.0e30f, lsum = 0.f;
    f32x4 o[4];
#pragma unroll
    for (int dt = 0; dt < 4; ++dt) o[dt] = (f32x4){0.f, 0.f, 0.f, 0.f};
    NA_ISSUE(0); NA_ISSUE(1); NA_STORE(0);
    __syncthreads();
#pragma unroll
    for (int sidx = 0; sidx < 2 * NCH; ++sidx) {
        if (sidx + 2 < 2 * NCH) NA_ISSUE(sidx + 2);
        const LAS bf16* cb = buf + (sidx & 1) * 9216 + hh * 4608;
        if (sidx < NCH) {
            const int c = sidx;
            if (LOCAL && c < 8) {
#pragma unroll
                for (int t2 = 0; t2 < 2; ++t2) {
                    const LAS bf16* kp = cb + (kc0 + 16 * t2 + fr) * 72 + 8 * fq;
                    f32x4 acc = {0.f, 0.f, 0.f, 0.f};
                    acc = __builtin_amdgcn_mfma_f32_16x16x32_bf16(*(const LAS bf16x8*)(kp), qf[0], acc, 0, 0, 0);
                    acc = __builtin_amdgcn_mfma_f32_16x16x32_bf16(*(const LAS bf16x8*)(kp + 32), qf[1], acc, 0, 0, 0);
                    const LAS float* rb = rpb + (r0 + c - gr + 7) * 31 + 15 - qcol;
#pragma unroll
                    for (int e = 0; e < 4; ++e) { const int kcol = kc0 + 16 * t2 + 4 * fq + e; const bool ok = (kcol >= cs) && (kcol < cs + 16);
                        const float sv = ok ? acc[e] * 0.125f + rb[ok ? kcol : qcol] : -1.0e30f; acc[e] = sv; m = fmaxf(m, sv); }
                    sl[2 * (c < 8 ? c : 0) + t2] = acc; }
            } else {
                const int cc = c - NLOC;
#pragma unroll
                for (int t4 = 0; t4 < 4; ++t4) {
                    const LAS bf16* kp = cb + (16 * t4 + fr) * 72 + 8 * fq;
                    f32x4 acc = {0.f, 0.f, 0.f, 0.f};
                    acc = __builtin_amdgcn_mfma_f32_16x16x32_bf16(*(const LAS bf16x8*)(kp), qf[0], acc, 0, 0, 0);
                    acc = __builtin_amdgcn_mfma_f32_16x16x32_bf16(*(const LAS bf16x8*)(kp + 32), qf[1], acc, 0, 0, 0);
#pragma unroll
                    for (int e = 0; e < 4; ++e) { acc[e] *= 0.125f; m = fmaxf(m, acc[e]); }
                    sc[4 * (cc >= 0 ? cc : 0) + t4] = acc; }
            }
            if (sidx == NCH - 1) { m = fmaxf(m, __shfl_xor(m, 16)); m = fmaxf(m, __shfl_xor(m, 32)); }
        } else {
            const int c = sidx - NCH;
            if (LOCAL && c < 8) {
                float p[8];
#pragma unroll
                for (int e = 0; e < 4; ++e) { p[e] = __expf(sl[2 * (c < 8 ? c : 0)][e] - m); p[4 + e] = __expf(sl[2 * (c < 8 ? c : 0) + 1][e] - m); }
#pragma unroll
                for (int e = 0; e < 8; ++e) lsum += p[e];
                const bf16x8 pf = __builtin_bit_cast(bf16x8, (v4u){pg8::cvt_pk_bf16(p[0], p[1]), pg8::cvt_pk_bf16(p[2], p[3]), pg8::cvt_pk_bf16(p[4], p[5]), pg8::cvt_pk_bf16(p[6], p[7])});
#pragma unroll
                for (int dt = 0; dt < 4; ++dt) { const LAS bf16* vp = cb + (16 * dt + fr) * 72 + kc0 + 4 * fq;
                    o[dt] = __builtin_amdgcn_mfma_f32_16x16x32_bf16(frag44(vp, vp + 16), pf, o[dt], 0, 0, 0); }
            } else {
                const int cc = c - NLOC;
#pragma unroll
                for (int p2 = 0; p2 < 2; ++p2) {
                    float p[8];
#pragma unroll
                    for (int e = 0; e < 4; ++e) { p[e] = __expf(sc[4 * (cc >= 0 ? cc : 0) + 2 * p2][e] - m); p[4 + e] = __expf(sc[4 * (cc >= 0 ? cc : 0) + 2 * p2 + 1][e] - m); }
#pragma unroll
                    for (int e = 0; e < 8; ++e) lsum += p[e];
                    const bf16x8 pf = __builtin_bit_cast(bf16x8, (v4u){pg8::cvt_pk_bf16(p[0], p[1]), pg8::cvt_pk_bf16(p[2], p[3]), pg8::cvt_pk_bf16(p[4], p[5]), pg8::cvt_pk_bf16(p[6], p[7])});
#pragma unroll
                    for (int dt = 0; dt < 4; ++dt) { const LAS bf16* vp = cb + (16 * dt + fr) * 72 + 32 * p2 + 4 * fq;
                        o[dt] = __builtin_amdgcn_mfma_f32_16x16x32_bf16(frag44(vp, vp + 16), pf, o[dt], 0, 0, 0); }
                }
            }
        }
        if (sidx + 1 < 2 * NCH) NA_STORE(sidx + 1);
        __syncthreads();
    }
#undef NA_TOKBASE
#undef NA_ISSUE
#undef NA_STORE
    lsum += __shfl_xor(lsum, 16); lsum += __shfl_xor(lsum, 32);
    const float inv = 1.f / lsum;
    bf16* op = YCAT + (size_t)(qrow0 + fr) * D + 512 + h * 64 + 4 * fq;
#pragma unroll
    for (int dt = 0; dt < 4; ++dt) { v2u w; w.x = pg8::cvt_pk_bf16(o[dt][0] * inv, o[dt][1] * inv); w.y = pg8::cvt_pk_bf16(o[dt][2] * inv, o[dt][3] * inv); *(v2u*)(op + dt * 16) = w; }
}
__device__ __forceinline__ void na_phase(const Args& a, int l, bool last, unsigned char* lds, int G) {
    const bf16* P = (const bf16*)(a.ws + WS_P); const bf16* VT = (const bf16*)(a.ws + WS_VT); bf16* YCAT = (bf16*)(a.ws + WS_YCAT);
    LAS bf16* buf = (LAS bf16*)((LAS unsigned char*)lds);
    LAS float* rpb_l = (LAS float*)((LAS unsigned char*)lds + 36864);
    __syncthreads();
    { float rv[8];
#pragma unroll
        for (int j = 0; j < 8; ++j) { const int i = threadIdx.x + NTHR * j; rv[j] = a.in[I_RPB][(size_t)l * NH * 15 * 31 + (i < NH * 15 * 31 ? i : 0)]; }
#pragma unroll
        for (int j = 0; j < 8; ++j) { const int i = threadIdx.x + NTHR * j; if (i < NH * 15 * 31) rpb_l[i] = rv[j]; } }
    const int nunits = 2048 + (last ? 0 : 256);
    const int per_x = (nunits + 7) / 8, xcd = blockIdx.x & 7, slot = blockIdx.x >> 3, nslot = (G + 7) / 8;
    const bool xord = (G % 8 == 0);
    for (int it = 0;; ++it) {
        int u;
        if (xord) { const int off = slot + it * nslot; if (off >= per_x) break; u = xcd * per_x + off; if (u >= nunits) continue; }
        else { u = blockIdx.x + it * G; if (u >= nunits) break; }
        int tid = threadIdx.x; asm volatile("" : "+v"(tid));
        __syncthreads();
        if (u < 2048) na_unit<true>(P, VT, YCAT, rpb_l, buf, u >> 7, (u >> 2) & 31, u & 3, 0, tid);
        else { const int u2 = u - 2048; na_unit<false>(P, VT, YCAT, rpb_l, buf, u2 >> 4, 0, (u2 >> 2) & 3, u2 & 3, tid); }
    }
}

__device__ __forceinline__ void final_phase(const Args& a, const float* mods_prev, int G) {
    const int tid = threadIdx.x, lane = tid & 63, wave = tid >> 6;
    const int gw = blockIdx.x * NWAVES + wave, NGW = G * NWAVES;
    const bf16* XS = (const bf16*)(a.ws + WS_XS); const bf16* YS = (const bf16*)(a.ws + WS_YS); const unsigned* route = (const unsigned*)(a.ws + WS_ROUTE);
    const float* fg = a.in[I_FING];
    constexpr int NR = 4;
    for (int row0 = NCTX + gw; row0 < NTOK; row0 += NR * NGW) {
        int rows[NR]; bool has[NR]; unsigned s0[NR], s1[NR]; f32x4 vv[NR][4]; v2u y0[NR][4], y1[NR][4];
#pragma unroll
        for (int r = 0; r < NR; ++r) { has[r] = row0 + r * NGW < NTOK; rows[r] = has[r] ? row0 + r * NGW : row0; s0[r] = route[(size_t)rows[r] * 8 + 6]; s1[r] = route[(size_t)rows[r] * 8 + 7]; }
#pragma unroll
        for (int r = 0; r < NR; ++r) row_load<false>(XS, XS + (size_t)NCTX * D, rows[r], lane, vv[r]);
#pragma unroll
        for (int r = 0; r < NR; ++r)
#pragma unroll
            for (int j = 0; j < 4; ++j) { const int c = 4 * lane + 256 * j; y0[r][j] = *(const v2u*)(YS + (size_t)s0[r] * D + c); y1[r][j] = *(const v2u*)(YS + (size_t)s1[r] * D + c); }
#pragma unroll
        for (int r = 0; r < NR; ++r) if (has[r]) { const int row = rows[r];
            const float* g5 = mods_prev + row_mrow(row) * MODW + 5 * D; float ss = 0.f;
#pragma unroll
            for (int j = 0; j < 4; ++j) { const int c = 4 * lane + 256 * j; const f32x4 gg = *(const f32x4*)(g5 + c); f32x4& v = vv[r][j]; const v2u ya = y0[r][j], yb = y1[r][j];
                v.x += gg.x * (bf2f(ya.x & 0xffffu) + bf2f(yb.x & 0xffffu)); v.y += gg.y * (bf2f(ya.x >> 16) + bf2f(yb.x >> 16));
                v.z += gg.z * (bf2f(ya.y & 0xffffu) + bf2f(yb.y & 0xffffu)); v.w += gg.w * (bf2f(ya.y >> 16) + bf2f(yb.y >> 16));
                ss += (v.x * v.x + v.y * v.y) + (v.z * v.z + v.w * v.w); }
            const float rstd = rsqrtf(wave_sum(ss) * (1.f / D) + RMS_EPS);
#pragma unroll
            for (int j = 0; j < 4; ++j) { const int c = 4 * lane + 256 * j; const f32x4 g = *(const f32x4*)(fg + c);
                *(f32x4*)(a.out + (size_t)(row - NCTX) * D + c) = vv[r][j] * rstd * g; }
        }
    }
}

constexpr int NPL = 17;
constexpr int NPHASES = 1 + DEPTH * NPL + 1;
__host__ __device__ constexpr bool phase_active(int p) {
    if (p == 0 || p == NPHASES - 1) return true;
    const int l = (p - 1) / NPL, k = (p - 1) % NPL;
    return (l & 1) ? (k <= 7 + MOE_NGROUPS) : (k <= 7);
}

#define PH(p) if (lo <= (p) && (p) < hi)
#define PH_END(p) do { if ((p) + 1 < hi) xcd_barrier(bar); } while (0)
template <int l>
__device__ __forceinline__ void layer_body(const Args& args, unsigned char* lds, const XcdBarrier& bar, int G, int lo, int hi) {
    {
        constexpr int pb = 1 + l * NPL;
        if (pb + NPL <= lo || pb >= hi) return;
        unsigned* ctl = (unsigned*)(args.ws + WS_CTL);
        const float* MODS = (const float*)(args.ws + WS_MODS);
        bf16* XS = (bf16*)(args.ws + WS_XS);
        LAS unsigned char* L = (LAS unsigned char*)lds;
        constexpr bool last = (l == DEPTH - 1), moe = (l & 1);
        const float* mods_l = MODS + (size_t)l * 17 * MODW;
        const void* src_ctx = (l == 0) ? (const void*)args.in[I_CTX] : (const void*)XS;
        const void* src_lat = (l == 0) ? (const void*)args.in[I_X] : (const void*)(XS + (size_t)NCTX * D);
        const int flo = last ? NCTX : 0, ftile0 = last ? 16 : 0, fntile = last ? 128 : 144;
        unsigned* cnt = ctl + CW_CNT + (l >> 1) * 512;
        constexpr int NCONV = 32, CONV_N1 = 256 * MK_CONV_A, CONV_N2 = CONV_N1 + 256 * MK_CONV_B;
        constexpr int CONV_T1r = CONV_N2 + 96 * 8 * MK_CONV_C, CONV_T1 = CONV_T1r < MOE_CONV_ITEMS ? CONV_T1r : MOE_CONV_ITEMS;
        constexpr int CONV_T2r = CONV_T1 + 160 * 8 * MK_CONV_D, CONV_T2 = CONV_T2r < MOE_CONV_ITEMS ? CONV_T2r : MOE_CONV_ITEMS;
        constexpr int CONV_T3r = CONV_T2 + 128 * 8 * MK_CONV_E, CONV_T3 = CONV_T3r < MOE_CONV_ITEMS ? CONV_T3r : MOE_CONV_ITEMS;
        const int wave_ = (int)(threadIdx.x >> 6), lane_ = (int)(threadIdx.x & 63);
        const bool deleg = (G == 256) && !moe;
        const int GC = deleg ? G - NCONV : G;
        const bool convwg = deleg && (int)blockIdx.x >= GC;
        const int cwave = ((int)blockIdx.x - GC) * NWAVES + (int)(threadIdx.x >> 6);

        PH(pb + 0) {
            if (l == 2) norm_phase<1>(args, src_ctx, src_lat, args.in[I_NMG] + l * D, mods_l, 0, 1, MODS + (size_t)(l - 1) * 17 * MODW, 0, NTOK, G);
            else if (l == 0) norm_phase<0, true>(args, src_ctx, src_lat, args.in[I_NMG] + l * D, mods_l, 0, 1, nullptr, 0, NTOK, G);
            else norm_phase<3>(args, src_ctx, src_lat, args.in[I_NMG] + l * D, mods_l, 0, 1, nullptr, 0, NTOK, G);
            if (moe) convert_moe_range(args, l >> 1, lds, (G == 256) ? CONV_T3 : 0, MOE_CONV_ITEMS, blockIdx.x * NWAVES + (threadIdx.x >> 6), G * NWAVES, threadIdx.x >> 6, threadIdx.x & 63);
            PH_END(pb + 0); }
        PH(pb + 1) {
            if (convwg) convert_moe_range(args, l >> 1, lds, 0, CONV_N1, cwave, NCONV * NWAVES, threadIdx.x >> 6, threadIdx.x & 63);
            else {
            pg8::SchedIn S{GC, (int)blockIdx.x, (const char*)(args.ws + WS_H), (const char*)(args.ws + WS_WIN + (size_t)l * 3584 * 1024 * 2)};
            pg8::EpiIn E{(bf16*)(args.ws + WS_P), (bf16*)(args.ws + WS_VT)};
            pg8::gemm_phase<pg8::EpiIn, pg8::SchedIn>(L, 1024, S, E); }
            PH_END(pb + 1); }
        PH(pb + 2) { scan_phase(args, l, last, lds, G); PH_END(pb + 2); }
        PH(pb + 3) { if (blockIdx.x & 8) { na_phase(args, l, last, lds, G); __syncthreads(); readout_phase(args, l, flo, NTOK, lds, G); } else { readout_phase(args, l, flo, NTOK, lds, G); __syncthreads(); na_phase(args, l, last, lds, G); } PH_END(pb + 3); }
        PH(pb + 4) {
            if (convwg) convert_moe_range(args, l >> 1, lds, CONV_N1, CONV_N2, cwave, NCONV * NWAVES, threadIdx.x >> 6, threadIdx.x & 63);
            else {
            pg8::SchedS S; S.init(args.ws + WS_YCAT, args.ws + WS_WOUT + (size_t)l * D * D * 2, 1024, ftile0, fntile, 4, GC, (int)blockIdx.x);
            pg8::EpiRes<l == 0> E{XS, src_ctx, src_lat, mods_l, 2 * D};
            pg8::gemm_phase<pg8::EpiRes<l == 0>, pg8::SchedS>(L, 1024, S, E);
            if (deleg && (int)blockIdx.x >= 128) convert_moe_range(args, l >> 1, lds, CONV_N2, CONV_T1, ((int)blockIdx.x - 128) * NWAVES + wave_, 96 * NWAVES, wave_, lane_); }
            PH_END(pb + 4); }
        PH(pb + 5) {
            if (moe) norm_route_phase(args, args.in[I_NFG] + l * D, mods_l, args.in[I_ROUTER] + (size_t)(l >> 1) * D * NEXP, cnt, flo, NTOK, lds, G);
            else norm_phase<0>(args, XS, XS + (size_t)NCTX * D, args.in[I_NFG] + l * D, mods_l, 3, 4, nullptr, flo, NTOK, G);
            PH_END(pb + 5); }
        if (!moe) {
            PH(pb + 6) {
                pg8::SchedS S; S.init(args.ws + WS_H, args.ws + WS_WUP + (size_t)(l >> 1) * 5632 * 1024 * 2, 1024, ftile0, fntile, 22, G, (int)blockIdx.x);
                pg8::EpiSwi E{(bf16*)(args.ws + WS_T), DFF, 0};
                pg8::gemm_phase<pg8::EpiSwi, pg8::SchedS>(L, 1024, S, E);
                if (deleg && (int)blockIdx.x >= 96) convert_moe_range(args, l >> 1, lds, CONV_T1, CONV_T2, ((int)blockIdx.x - 96) * NWAVES + wave_, 160 * NWAVES, wave_, lane_);
                PH_END(pb + 6); }
            PH(pb + 7) {
                pg8::SchedS S; S.init(args.ws + WS_T, args.ws + WS_WDN + (size_t)(l >> 1) * 1024 * DFF * 2, DFF, 16, 128, 4, G, (int)blockIdx.x);
                pg8::EpiRes<false> E{XS, XS, XS + (size_t)NCTX * D, mods_l, 5 * D};
                pg8::gemm_phase<pg8::EpiRes<false>, pg8::SchedS>(L, DFF, S, E);
                __syncthreads();
                pg8::SchedK2 S2; S2.init(args.ws + WS_T, args.ws + WS_WDN + (size_t)(l >> 1) * 1024 * DFF * 2, DFF, 0, 16, 8, G, (int)blockIdx.x); S2.khb = (DFF / 2) * 2;
                pg8::EpiDelta E2{(bf16*)(args.ws + WS_DB2), (size_t)(WS_DB2B - WS_DB2) / 2, mods_l, 5 * D};
                pg8::gemm_phase<pg8::EpiDelta, pg8::SchedK2>(L, DFF / 2, S2, E2, DFF);
                if (deleg && (int)blockIdx.x >= 128) convert_moe_range(args, l >> 1, lds, CONV_T2, CONV_T3, ((int)blockIdx.x - 128) * NWAVES + wave_, 128 * NWAVES, wave_, lane_);
                PH_END(pb + 7); }
        } else {
            PH(pb + 6) { gather_phase(args, cnt, flo, NTOK, lds, G); PH_END(pb + 6); }
            for (int k = 0; k <= MOE_NGROUPS; ++k) {
                PH(pb + 7 + k) {
                    __syncthreads();
                    LAS unsigned* tab = (LAS unsigned*)((LAS unsigned char*)lds + 131072);
                    moe_ranges(cnt, tab);
                    pg8::SchedE S; const int nused = (int)(tab[15] >> 8);
#pragma unroll
                    for (int e = 0; e < 8; ++e) S.tend[e] = (int)(tab[8 + e] >> 8);
#define MOE_T0(g_) ((g_) == 0 ? (MOE_NGROUPS - 1) * MOE_GROUP : ((g_) - 1) * MOE_GROUP)
                    LAS int* list0 = (LAS int*)(tab + 32); LAS int* list1 = (LAS int*)(tab + 96);
                    {
                        int nMd = 0, nMu = 0;
                        if (k >= 1) { nMd = nused - MOE_T0(k - 1); nMd = nMd > MOE_GROUP ? MOE_GROUP : (nMd < 0 ? 0 : nMd); }
                        if (k < MOE_NGROUPS) { nMu = nused - MOE_T0(k); nMu = nMu > MOE_GROUP ? MOE_GROUP : (nMu < 0 ? 0 : nMu); }
                        const int ndn = nMd * 4, nup = nMu * 28;
                        moe_fill_list(list0, ndn, G, (int)blockIdx.x, 0);
                        moe_fill_list(list1, nup, G, (int)blockIdx.x, (ndn > 0 && ndn < G && nup >= 2 * G) ? ndn : 0);
                        __syncthreads(); }
                    if (k >= 1) { const int g = k - 1, t0 = MOE_T0(g); int nM = nused - t0; nM = nM > MOE_GROUP ? MOE_GROUP : nM;
                        S.init(args.ws + WS_TM + (size_t)(g & 1) * 112 * MiB, args.ws + WS_MDN, DFFE, t0, nM, 4, G, (int)blockIdx.x); S.asub = t0; S.bes = (size_t)1024 * 3584 * 2; S.list = list0;
                        pg8::EpiMoeDn E{(bf16*)(args.ws + WS_YS), (const float*)(args.ws + WS_SLOTG)};
                        pg8::gemm_phase<pg8::EpiMoeDn, pg8::SchedE>(L, DFFE, S, E);
                        __syncthreads(); }
                    if (k < MOE_NGROUPS) { const int g = k, t0 = MOE_T0(g); int nM = nused - t0; nM = nM > MOE_GROUP ? MOE_GROUP : nM;
                        S.init(args.ws + WS_XG, args.ws + WS_MUP, 1024, t0, nM, 28, G, (int)blockIdx.x); S.asub = 0; S.bes = (size_t)7168 * 1024 * 2;
                        S.list = list1;
                        pg8::EpiSwi E{(bf16*)(args.ws + WS_TM + (size_t)(g & 1) * 112 * MiB), DFFE, t0};
                        pg8::gemm_phase<pg8::EpiSwi, pg8::SchedE>(L, 1024, S, E); }
#undef MOE_T0
                    PH_END(pb + 7 + k); }
            }
        }
    }
}

__global__ void __launch_bounds__(NTHR, 2) mk_fwd(Args args) {
    extern __shared__ __attribute__((aligned(16))) unsigned char lds[];
    const int G = gridDim.x, lo = args.ph_lo, hi = args.ph_hi;
    volatile LAS unsigned* xbw = (volatile LAS unsigned*)((LAS unsigned char*)lds + LDS_BYTES - 64);
    if (threadIdx.x < 4) xbw[threadIdx.x] = 0u;
    __syncthreads();
    unsigned* ctl = (unsigned*)(args.ws + WS_CTL);
    XcdBarrier bar; bar.bar = ctl + CW_BAR; bar.x = 0; bar.st = xbw;
    if (hi - lo > 1) bar = xcd_barrier_post(ctl + CW_BAR, xbw);
    const float* MODS = (const float*)(args.ws + WS_MODS);
    LAS unsigned char* L = (LAS unsigned char*)lds;

    PH(0) { prologue_phase(args, lds, G); PH_END(0); }

    layer_body<0>(args, lds, bar, G, lo, hi);
    layer_body<1>(args, lds, bar, G, lo, hi);
    layer_body<2>(args, lds, bar, G, lo, hi);
    layer_body<3>(args, lds, bar, G, lo, hi);
    PH(NPHASES - 1) { final_phase(args, MODS + (size_t)(DEPTH - 1) * 17 * MODW, G); }
#undef PH
#undef PH_END
}

extern "C" void kernel_launch(void* const* d_in, const int* in_sizes, int n_in, void* d_out, int out_size, void* d_ws, size_t ws_size, hipStream_t stream) {
    static int grid = 0;
    if (grid == 0) {
        if (n_in != 30 || out_size != NLAT * D || ws_size < WS_END) { fprintf(stderr, "kernel_launch: unexpected shapes (n_in %d out %d ws %zu)\n", n_in, out_size, ws_size); grid = -1; return; }
        int dev = 0, cus = 0;
        if (hipGetDevice(&dev) != hipSuccess || hipDeviceGetAttribute(&cus, hipDeviceAttributeMultiprocessorCount, dev) != hipSuccess) { grid = -1; return; }
        if (hipFuncSetAttribute((const void*)mk_fwd, hipFuncAttributeMaxDynamicSharedMemorySize, LDS_BYTES) != hipSuccess) { grid = -1; return; }
        int per_cu = 0;
        if (hipOccupancyMaxActiveBlocksPerMultiprocessor(&per_cu, (const void*)mk_fwd, NTHR, LDS_BYTES) != hipSuccess || per_cu < 1) { fprintf(stderr, "kernel_launch: occupancy query says %d\n", per_cu); }
        (void)hipGetLastError();
        grid = cus > 0 ? cus : 256;
    }
    if (grid < 0) return;
    (void)hipMemsetAsync((char*)d_ws + WS_CTL, 0, CTL_BYTES, stream);
    Args a{};
    for (int i = 0; i < 30; ++i) a.in[i] = (const float*)d_in[i];
    a.out = (float*)d_out; a.ws = (unsigned char*)d_ws;
#if MK_ONE_LAUNCH
    a.ph_lo = 0; a.ph_hi = NPHASES;
    hipLaunchKernelGGL(mk_fwd, dim3(grid), dim3(NTHR), LDS_BYTES, stream, a);
#else
    for (int p = 0; p < NPHASES; ++p) {
        if (!phase_active(p)) continue;
        a.ph_lo = p; a.ph_hi = p + 1;
        hipLaunchKernelGGL(mk_fwd, dim3(grid), dim3(NTHR), LDS_BYTES, stream, a);
    }
#endif
}
```

```cpp
#include <hip/hip_runtime.h>
#include <cstdio>
#include <cstdint>

#define GAS __attribute__((address_space(1)))
#define LAS __attribute__((address_space(3)))

#ifndef MK_ONE_LAUNCH
#define MK_ONE_LAUNCH 1
#endif

#ifndef MK_CONV_A
#define MK_CONV_A 70
#endif
#ifndef MK_CONV_B
#define MK_CONV_B 30
#endif
#ifndef MK_CONV_C
#define MK_CONV_C 6
#endif
#ifndef MK_CONV_D
#define MK_CONV_D 6
#endif
#ifndef MK_CONV_E
#define MK_CONV_E 5
#endif

constexpr int BATCH = 16, SEQ = 2048, CTXL = 256, D = 1024, DEPTH = 4;
constexpr int NCTX = BATCH * CTXL;
constexpr int NLAT = BATCH * SEQ;
constexpr int NTOK = NCTX + NLAT;
constexpr int DRW = 512, HD = 64, NH = 8;
constexpr int DSHIFT = 1920, DIN = 3456, DINP = 3072, URW = 1024;
constexpr int DFF = 2816, NEXP = 8, DFFE = 3584;
constexpr int MODW = 6 * D;
constexpr int MOE_GROUP = 64;
constexpr int MOE_NGROUPS = 5;
constexpr int MAXSLOTS = (2 * NTOK / 256 + NEXP) * 256;
constexpr float RMS_EPS = 1e-6f, GN_EPS = 64e-5f;

constexpr size_t MiB = 1u << 20;
constexpr size_t WS_CTL = 0, CTL_BYTES = 1 * MiB;
constexpr size_t WS_MODS = 1 * MiB;
constexpr size_t WS_ROUTE = 3 * MiB;
constexpr size_t WS_SLOTG = 4 * MiB + 512 * 1024;
constexpr size_t WS_G2T = 5 * MiB;
constexpr size_t WS_WIN = 6 * MiB;
constexpr size_t WS_WOUT = 34 * MiB;
constexpr size_t WS_WUP = 42 * MiB;
constexpr size_t WS_WDN = 64 * MiB;
constexpr size_t WS_MUP = 75 * MiB;
constexpr size_t WS_MDN = 187 * MiB;
constexpr size_t WS_XS = 243 * MiB;
constexpr size_t WS_H = 387 * MiB;
constexpr size_t WS_U = 459 * MiB;
constexpr size_t WS_P = WS_U;
constexpr size_t WS_VT = WS_U + 216 * MiB;
constexpr size_t WS_YD = WS_U + 252 * MiB;
constexpr size_t WS_SB = WS_U + 396 * MiB;
constexpr size_t WS_YCAT = WS_U + 399 * MiB;
constexpr size_t WS_DB2 = WS_U + 252 * MiB;
constexpr size_t WS_DB2B = WS_U + 260 * MiB;
constexpr size_t WS_T = WS_U;
constexpr size_t WS_XG = WS_U;
constexpr size_t WS_YS = WS_XG;
constexpr size_t WS_TM = WS_U + 148 * MiB;
constexpr size_t WS_END = 931 * MiB;
constexpr int CW_BAR = 4096;
constexpr int CW_CNT = 8192;

constexpr int LDS_BYTES = 147456;
constexpr int NWAVES = 8, NTHR = 512;

typedef unsigned short bf16;
typedef unsigned v4u __attribute__((ext_vector_type(4)));
typedef unsigned v2u __attribute__((ext_vector_type(2)));
typedef float f32x4 __attribute__((ext_vector_type(4)));
typedef float f32x2 __attribute__((ext_vector_type(2)));

__device__ __forceinline__ float bf2f(unsigned b) { return __uint_as_float(b << 16); }
__device__ __forceinline__ unsigned f2bf(float f) { unsigned u = __float_as_uint(f); return (u + 0x7fffu + ((u >> 16) & 1u)) >> 16; }
__device__ __forceinline__ unsigned pk2(float lo, float hi) { return f2bf(lo) | (f2bf(hi) << 16); }
__device__ __forceinline__ float wave_sum(float v) {
#pragma unroll
    for (int o = 1; o < 64; o <<= 1) v += __shfl_xor(v, o);
    return v;
}
__device__ __forceinline__ float sigmoidf_(float x) { return __builtin_amdgcn_rcpf(1.f + __expf(-x)); }

namespace pg8 {
#define PG8_LAS __attribute__((address_space(3)))
typedef unsigned short bf16_t;
typedef short bf16x8 __attribute__((ext_vector_type(8)));
typedef unsigned u32x4 __attribute__((ext_vector_type(4)));
constexpr int BM = 256, BK = 64, HALF = 128, HTB = HALF * BK * 2, STAGE_BYTES = 8 * HTB, NXCD = 8, WGM = 8;

__host__ __device__ __forceinline__ int lds_byte(int r, int c) { const int st = (r >> 4) * 2 + (c >> 5), rr = r & 15, cc = c & 31, ob = rr * 64 + cc * 2; return st * 1024 + (ob ^ (((ob >> 9) & 1) << 5)); }
__host__ __device__ __forceinline__ void stage_rc(int b, int& R, int& C) { const int st = b / 1024, sb = b % 1024, swz = sb ^ (((sb >> 9) & 1) << 5); R = (st >> 1) * 16 + swz / 64; C = (st & 1) * 32 + (swz % 64) / 2; }
__host__ __device__ __forceinline__ int perm32(int rho) { const int n = rho >> 4, i = rho & 15; return 8 * (i >> 2) + 4 * n + (i & 3); }

struct Unit { int pm, pn; };

struct SchedS {
    int nM, nN, nwg, G, c, pm0; const char* A; const char* Bt; size_t ats, bts;
    __device__ __forceinline__ void init(const void* A_, const void* Bt_, int K, int pm0_, int nM_, int nN_, int G_, int c_) {
        A = (const char*)A_; Bt = (const char*)Bt_; ats = (size_t)BM * K * 2; bts = ats; pm0 = pm0_; nM = nM_ > 0 ? nM_ : 0; nN = nN_; nwg = nM * nN; G = G_; c = c_; }
    __device__ __forceinline__ bool unit_of(long L, Unit& u) const {
        if (L >= nwg) return false;
        int wgid = (int)L; { const int q = nwg / NXCD, r = nwg % NXCD, xcd = wgid % NXCD, off = wgid / NXCD; wgid = (xcd < r ? xcd * (q + 1) : r * (q + 1) + (xcd - r) * q) + off; }
        const int nig = WGM * nN, gid = wgid / nig, fm = gid * WGM, gsz = (nM - fm) < WGM ? (nM - fm) : WGM;
        u.pm = pm0 + fm + ((wgid % nig) % gsz); u.pn = (wgid % nig) / gsz; return true;
    }
    __device__ __forceinline__ bool next(int i, Unit& u) const { return unit_of((long)i * G + c, u); }
    __device__ __forceinline__ const char* a_base(const Unit& u) const { return A + (size_t)u.pm * ats; }
    __device__ __forceinline__ const char* b_base(const Unit& u) const { return Bt + (size_t)u.pn * bts; }
    __device__ __forceinline__ void a_ready(const Unit&) const {}
    __device__ __forceinline__ void done(const Unit&) const {}
};
struct SchedK2 : SchedS {
    size_t khb;
    __device__ __forceinline__ const char* a_base(const Unit& u) const { return A + (size_t)u.pm * ats + (size_t)(u.pn & 1) * khb; }
    __device__ __forceinline__ const char* b_base(const Unit& u) const { return Bt + (size_t)(u.pn >> 1) * bts + (size_t)(u.pn & 1) * khb; }
};
struct SchedE : SchedS {
    int tend[8]; int asub; size_t bes;
    const PG8_LAS int* list;
    __device__ __forceinline__ bool next(int i, Unit& u) const { if (i >= 64) return false; return unit_of((long)__builtin_amdgcn_readfirstlane(list[i]), u); }
    __device__ __forceinline__ const char* a_base(const Unit& u) const { return A + (size_t)(u.pm - asub) * ats; }
    __device__ __forceinline__ const char* b_base(const Unit& u) const {
        int e = 0;
#pragma unroll
        for (int j = 0; j < 7; ++j) e += (u.pm >= tend[j]) ? 1 : 0;
        return Bt + (size_t)e * bes + (size_t)u.pn * bts; }
};

typedef __bf16 bf16x2_t __attribute__((ext_vector_type(2)));
__device__ __forceinline__ unsigned cvt_pk_bf16(float lo, float hi) { const float __attribute__((ext_vector_type(2))) v = {lo, hi}; return __builtin_bit_cast(unsigned, __builtin_convertvector(v, bf16x2_t)); }

struct EpiP {
    static constexpr bool PERM = true, AFTER_DRAIN = false;
    bf16_t* O; int ldc;
    __device__ __forceinline__ void operator()(const f32x4 (&acc)[2][2][4][2], const Unit& u, int wr, int wc, int fr, int fq) const {
        const int row0 = u.pm * BM + wr * 64 + fr, col0 = u.pn * BM + wc * 32 + 8 * fq;
#pragma unroll
        for (int ai = 0; ai < 2; ++ai)
#pragma unroll
            for (int m = 0; m < 4; ++m) { bf16_t* rowp = O + (size_t)(row0 + ai * HALF + m * 16) * ldc + col0;
#pragma unroll
                for (int bj = 0; bj < 2; ++bj) { const f32x4 v0 = acc[ai][bj][m][0], v1 = acc[ai][bj][m][1];
                    u32x4 w; w.x = cvt_pk_bf16(v0[0], v0[1]); w.y = cvt_pk_bf16(v0[2], v0[3]); w.z = cvt_pk_bf16(v1[0], v1[1]); w.w = cvt_pk_bf16(v1[2], v1[3]);
                    *(u32x4*)(rowp + bj * HALF) = w; } }
    }
};
struct SchedIn {
    int G, c; const char* Hm; const char* W;
    __device__ __forceinline__ bool next(int i, Unit& u) const {
        const int L = i * G + c; if (L >= 2016) return false;
        if (L < 1728) { int wgid = L; { const int q = 1728 / NXCD, xcd = wgid % NXCD, off = wgid / NXCD; wgid = xcd * q + off; }
            const int nig = WGM * 12, gid = wgid / nig, fm = gid * WGM; u.pm = fm + ((wgid % nig) % WGM); u.pn = (wgid % nig) / WGM; }
        else { const int L2 = L - 1728; u.pm = 1000 + (L2 & 1); u.pn = L2 >> 1; }
        return true; }
    __device__ __forceinline__ const char* a_base(const Unit& u) const { return u.pm >= 1000 ? W + (size_t)(3072 + (u.pm - 1000) * 256) * 2048 : Hm + (size_t)u.pm * 256 * 2048; }
    __device__ __forceinline__ const char* b_base(const Unit& u) const { return u.pm >= 1000 ? Hm + (size_t)u.pn * 256 * 2048 : W + (size_t)u.pn * 256 * 2048; }
    __device__ __forceinline__ void a_ready(const Unit&) const {}
    __device__ __forceinline__ void done(const Unit&) const {}
};
struct EpiIn {
    static constexpr bool PERM = true, AFTER_DRAIN = false;
    bf16_t* P; bf16_t* VT;
    __device__ __forceinline__ void operator()(const f32x4 (&acc)[2][2][4][2], const Unit& u, int wr, int wc, int fr, int fq) const {
        const bool tr = u.pm >= 1000; bf16_t* O = tr ? VT : P; const int ldc = tr ? 36864 : 3072, pm = tr ? u.pm - 1000 : u.pm;
        const int row0 = pm * BM + wr * 64 + fr, col0 = u.pn * BM + wc * 32 + 8 * fq;
#pragma unroll
        for (int ai = 0; ai < 2; ++ai)
#pragma unroll
            for (int m = 0; m < 4; ++m) { bf16_t* rowp = O + (size_t)(row0 + ai * HALF + m * 16) * ldc + col0;
#pragma unroll
                for (int bj = 0; bj < 2; ++bj) { const f32x4 v0 = acc[ai][bj][m][0], v1 = acc[ai][bj][m][1];
                    u32x4 w; w.x = cvt_pk_bf16(v0[0], v0[1]); w.y = cvt_pk_bf16(v0[2], v0[3]); w.z = cvt_pk_bf16(v1[0], v1[1]); w.w = cvt_pk_bf16(v1[2], v1[3]);
                    *(u32x4*)(rowp + bj * HALF) = w; } }
    }
};
struct EpiSwi {
    static constexpr bool PERM = true, AFTER_DRAIN = false;
    bf16_t* O; int ldc; int tsub;
    __device__ __forceinline__ void operator()(const f32x4 (&acc)[2][2][4][2], const Unit& u, int wr, int wc, int fr, int fq) const {
        const int row0 = (u.pm - tsub) * BM + wr * 64 + fr, col0 = u.pn * HALF + wc * 32 + 8 * fq;
#pragma unroll
        for (int ai = 0; ai < 2; ++ai)
#pragma unroll
            for (int m = 0; m < 4; ++m) { bf16_t* rowp = O + (size_t)(row0 + ai * HALF + m * 16) * ldc + col0;
                float t[8];
#pragma unroll
                for (int n = 0; n < 2; ++n)
#pragma unroll
                    for (int j = 0; j < 4; ++j) { const float g = acc[ai][0][m][n][j], up = acc[ai][1][m][n][j]; t[n * 4 + j] = g * __builtin_amdgcn_rcpf(1.f + __expf(-g)) * up; }
                u32x4 w; w.x = cvt_pk_bf16(t[0], t[1]); w.y = cvt_pk_bf16(t[2], t[3]); w.z = cvt_pk_bf16(t[4], t[5]); w.w = cvt_pk_bf16(t[6], t[7]);
                *(u32x4*)rowp = w; }
    }
};
template <bool BASEF32>
struct EpiRes {
    static constexpr bool PERM = true, AFTER_DRAIN = false;
    bf16_t* out; const void* base_ctx; const void* base_lat; const float* mods_l; int mcol;
    __device__ __forceinline__ void operator()(const f32x4 (&acc)[2][2][4][2], const Unit& u, int wr, int wc, int fr, int fq) const {
        const bool isctx = u.pm < 16;
        const size_t toff = isctx ? (size_t)u.pm * BM * 1024 : (size_t)(u.pm - 16) * BM * 1024;
        const float* gate = mods_l + (isctx ? 16 : ((u.pm - 16) >> 3)) * 6144 + mcol;
        bf16_t* o = out + (size_t)u.pm * BM * 1024;
        const int r0 = wr * 64 + fr, col0 = u.pn * BM + wc * 32 + 8 * fq;
        f32x4 gv[2][2];
#pragma unroll
        for (int bj = 0; bj < 2; ++bj)
#pragma unroll
            for (int n = 0; n < 2; ++n) gv[bj][n] = *(const f32x4*)(gate + col0 + bj * HALF + n * 4);
#pragma unroll
        for (int ai = 0; ai < 2; ++ai)
#pragma unroll
            for (int m0 = 0; m0 < 4; m0 += 4) {
                u32x4 wpre[4][2];
                if constexpr (!BASEF32) {
#pragma unroll
                    for (int mm = 0; mm < 4; ++mm)
#pragma unroll
                        for (int bj = 0; bj < 2; ++bj) wpre[mm][bj] = *(const u32x4*)((const bf16_t*)(isctx ? base_ctx : base_lat) + toff + (size_t)(r0 + ai * HALF + (m0 + mm) * 16) * 1024 + col0 + bj * HALF); }
#pragma unroll
                for (int mm = 0; mm < 4; ++mm) { const int m = m0 + mm; const size_t ro = (size_t)(r0 + ai * HALF + m * 16) * 1024 + col0;
#pragma unroll
                for (int bj = 0; bj < 2; ++bj) { f32x4 b0, b1;
                    if constexpr (BASEF32) { const float* b = (const float*)(isctx ? base_ctx : base_lat) + toff + ro + bj * HALF; b0 = *(const f32x4*)b; b1 = *(const f32x4*)(b + 4); }
                    else { const u32x4 w = wpre[mm][bj];
                        b0 = (f32x4){__uint_as_float(w.x << 16), __uint_as_float(w.x & 0xffff0000u), __uint_as_float(w.y << 16), __uint_as_float(w.y & 0xffff0000u)};
                        b1 = (f32x4){__uint_as_float(w.z << 16), __uint_as_float(w.z & 0xffff0000u), __uint_as_float(w.w << 16), __uint_as_float(w.w & 0xffff0000u)}; }
                    const f32x4 v0 = b0 + gv[bj][0] * acc[ai][bj][m][0], v1 = b1 + gv[bj][1] * acc[ai][bj][m][1];
                    u32x4 w; w.x = cvt_pk_bf16(v0[0], v0[1]); w.y = cvt_pk_bf16(v0[2], v0[3]); w.z = cvt_pk_bf16(v1[0], v1[1]); w.w = cvt_pk_bf16(v1[2], v1[3]);
                    *(u32x4*)(o + ro + bj * HALF) = w; } } }
    }
};
struct EpiDelta {
    static constexpr bool PERM = true, AFTER_DRAIN = false;
    bf16_t* Ob; size_t o2off; const float* mods_l; int mcol;
    __device__ __forceinline__ void operator()(const f32x4 (&acc)[2][2][4][2], const Unit& u, int wr, int wc, int fr, int fq) const {
        const float* gate = mods_l + (u.pm < 16 ? 16 : ((u.pm - 16) >> 3)) * 6144 + mcol;
        bf16_t* O = Ob + (size_t)(u.pn & 1) * o2off;
        const int row0 = u.pm * BM + wr * 64 + fr, col0 = (u.pn >> 1) * BM + wc * 32 + 8 * fq;
        f32x4 gv[2][2];
#pragma unroll
        for (int bj = 0; bj < 2; ++bj)
#pragma unroll
            for (int n = 0; n < 2; ++n) gv[bj][n] = *(const f32x4*)(gate + col0 + bj * HALF + n * 4);
#pragma unroll
        for (int ai = 0; ai < 2; ++ai)
#pragma unroll
            for (int m = 0; m < 4; ++m) { bf16_t* rowp = O + (size_t)(row0 + ai * HALF + m * 16) * 1024 + col0;
#pragma unroll
                for (int bj = 0; bj < 2; ++bj) { const f32x4 v0 = acc[ai][bj][m][0] * gv[bj][0], v1 = acc[ai][bj][m][1] * gv[bj][1];
                    u32x4 w; w.x = cvt_pk_bf16(v0[0], v0[1]); w.y = cvt_pk_bf16(v0[2], v0[3]); w.z = cvt_pk_bf16(v1[0], v1[1]); w.w = cvt_pk_bf16(v1[2], v1[3]);
                    *(u32x4*)(rowp + bj * HALF) = w; } }
    }
};
struct EpiMoeDn {
    static constexpr bool PERM = true, AFTER_DRAIN = false;
    bf16_t* O; const float* slotg;
    __device__ __forceinline__ void operator()(const f32x4 (&acc)[2][2][4][2], const Unit& u, int wr, int wc, int fr, int fq) const {
        const int row0 = u.pm * BM + wr * 64 + fr, col0 = u.pn * BM + wc * 32 + 8 * fq;
        float gs[2][4];
#pragma unroll
        for (int ai = 0; ai < 2; ++ai)
#pragma unroll
            for (int m = 0; m < 4; ++m) gs[ai][m] = slotg[row0 + ai * HALF + m * 16];
#pragma unroll
        for (int ai = 0; ai < 2; ++ai)
#pragma unroll
            for (int m = 0; m < 4; ++m) { const int row = row0 + ai * HALF + m * 16; const float g = gs[ai][m]; bf16_t* rowp = O + (size_t)row * 1024 + col0;
#pragma unroll
                for (int bj = 0; bj < 2; ++bj) { const f32x4 v0 = acc[ai][bj][m][0] * g, v1 = acc[ai][bj][m][1] * g;
                    u32x4 w; w.x = cvt_pk_bf16(v0[0], v0[1]); w.y = cvt_pk_bf16(v0[2], v0[3]); w.z = cvt_pk_bf16(v1[0], v1[1]); w.w = cvt_pk_bf16(v1[2], v1[3]);
                    *(u32x4*)(rowp + bj * HALF) = w; } }
    }
};

template <class Epi, class Sched, bool ALIGN_EPI = true>
__device__ __forceinline__ void gemm_phase(PG8_LAS unsigned char* lds, const int K, const Sched& S, const Epi& E, const int ldk_ = 0) {
    const int ldk = ldk_ ? ldk_ : K;
    const int tid = threadIdx.x, wid = __builtin_amdgcn_readfirstlane(tid >> 6), lane = tid & 63, wr = wid >> 2, wc = wid & 3, fr = lane & 15, fq = lane >> 4;
    const int nt = K / BK;
    unsigned voffA[2], voffB[2];
#pragma unroll
    for (int i = 0; i < 2; ++i) { int R, C; stage_rc(tid * 16 + i * 8192, R, C); const int Rb = Epi::PERM ? ((R & ~31) + perm32(R & 31)) : R;
        voffA[i] = (unsigned)(R * ldk + C) * 2u; voffB[i] = (unsigned)(Rb * ldk + C) * 2u; }
    const size_t kstep = (size_t)(BK * 2);
    const size_t hstep = (size_t)HALF * ldk * 2;
    const unsigned ldsw = (unsigned)wid * 1024u;
    const int aoff = lds_byte(wr * 64 + fr, fq * 8), boff = lds_byte(wc * 32 + fr, fq * 8);
#define PG8_SA(b, h) (((b) * 2 + (h)) * HTB)
#define PG8_SB(b, h) ((4 + (b) * 2 + (h)) * HTB)
#define PG8_STAGE(bufoff, gbase, voff) do { _Pragma("unroll") for (int _i = 0; _i < 2; ++_i) \
        __builtin_amdgcn_global_load_lds((const unsigned*)((const char*)(gbase) + (voff)[_i]), (PG8_LAS unsigned*)(lds + (bufoff) + ldsw + _i * 8192), 16, 0, 0); } while (0)
#define PG8_LDA(dst, b, h) do { _Pragma("unroll") for (int m = 0; m < 4; ++m) _Pragma("unroll") for (int k = 0; k < 2; ++k) dst[m][k] = *(const PG8_LAS bf16x8*)(lds + PG8_SA(b, h) + aoff + m * 2048 + k * 1024); } while (0)
#define PG8_LDB(dst, b, h) do { _Pragma("unroll") for (int n = 0; n < 2; ++n) _Pragma("unroll") for (int k = 0; k < 2; ++k) dst[n][k] = *(const PG8_LAS bf16x8*)(lds + PG8_SB(b, h) + boff + n * 2048 + k * 1024); } while (0)
#define PG8_MMA(ai, bj, At, Bt) do { __builtin_amdgcn_s_setprio(1); _Pragma("unroll") for (int m = 0; m < 4; ++m) _Pragma("unroll") for (int n = 0; n < 2; ++n) _Pragma("unroll") for (int k = 0; k < 2; ++k) \
        acc[ai][bj][m][n] = __builtin_amdgcn_mfma_f32_16x16x32_bf16(Bt[n][k], At[m][k], acc[ai][bj][m][n], 0, 0, 0); __builtin_amdgcn_s_setprio(0); } while (0)
#define PG8_WAIT_V(n) asm volatile("s_waitcnt vmcnt(" #n ")" ::: "memory")
#define PG8_WAIT_L(n) asm volatile("s_waitcnt lgkmcnt(" #n ")" ::: "memory")
#define PG8_BAR __builtin_amdgcn_s_barrier()
#define PG8_SCHED __builtin_amdgcn_sched_barrier(0)
    Unit cur, nxt; int ui = 0;
    if (!S.next(0, cur)) return;
    f32x4 acc[2][2][4][2];
#pragma unroll
    for (int a = 0; a < 2; ++a)
#pragma unroll
        for (int b = 0; b < 2; ++b)
#pragma unroll
            for (int m = 0; m < 4; ++m)
#pragma unroll
                for (int n = 0; n < 2; ++n) acc[a][b][m][n] = (f32x4){0.f, 0.f, 0.f, 0.f};
    bf16x8 At[4][2], B0[2][2], B1[2][2];
    const char* cA = S.a_base(cur); const char* cB = S.b_base(cur);
    S.a_ready(cur);
    PG8_STAGE(PG8_SB(0, 0), cB, voffB); PG8_STAGE(PG8_SB(0, 1), cB + hstep, voffB); PG8_STAGE(PG8_SA(0, 0), cA, voffA); PG8_STAGE(PG8_SA(0, 1), cA + hstep, voffA);
    if (wr == 1) PG8_BAR;
    PG8_WAIT_V(2); PG8_BAR;
    PG8_STAGE(PG8_SB(1, 0), cB + kstep, voffB); PG8_STAGE(PG8_SA(1, 0), cA + kstep, voffA); PG8_STAGE(PG8_SB(1, 1), cB + hstep + kstep, voffB);
    PG8_WAIT_V(6); PG8_BAR;
    for (;;) {
        const bool has_next = S.next(ui + 1, nxt);
        const char* nA = has_next ? S.a_base(nxt) : cA; const char* nB = has_next ? S.b_base(nxt) : cB;
        for (int t = 0; t < nt; t += 2) {
            const bool last = (t == nt - 2);
            const char* a1 = cA + (size_t)(t + 1) * kstep;
            const char* a2 = last ? nA : cA + (size_t)(t + 2) * kstep; const char* b2 = last ? nB : cB + (size_t)(t + 2) * kstep;
            const char* a3 = a2 + kstep; const char* b3 = b2 + kstep;
            if (last && has_next) S.a_ready(nxt);
            PG8_LDB(B0, 0, 0); PG8_LDB(B1, 0, 1); PG8_SCHED; PG8_LDA(At, 0, 0); PG8_STAGE(PG8_SA(1, 1), a1 + hstep, voffA);
            PG8_WAIT_V(8); PG8_WAIT_L(0); PG8_BAR; PG8_MMA(0, 0, At, B0); PG8_MMA(0, 1, At, B1); PG8_BAR; PG8_SCHED;
            PG8_LDA(At, 0, 1); PG8_STAGE(PG8_SB(0, 0), b2, voffB); PG8_STAGE(PG8_SB(0, 1), b2 + hstep, voffB); PG8_STAGE(PG8_SA(0, 0), a2, voffA);
            PG8_WAIT_V(8); PG8_WAIT_L(0); PG8_BAR; PG8_MMA(1, 0, At, B0); PG8_MMA(1, 1, At, B1); PG8_BAR; PG8_SCHED;
            PG8_LDB(B0, 1, 0); PG8_LDB(B1, 1, 1); PG8_SCHED; PG8_LDA(At, 1, 0); PG8_STAGE(PG8_SA(0, 1), a2 + hstep, voffA);
            PG8_WAIT_V(8); PG8_WAIT_L(0); PG8_BAR; PG8_MMA(0, 0, At, B0); PG8_MMA(0, 1, At, B1); PG8_BAR; PG8_SCHED;
            PG8_LDA(At, 1, 1); PG8_STAGE(PG8_SB(1, 0), b3, voffB); PG8_STAGE(PG8_SB(1, 1), b3 + hstep, voffB); PG8_STAGE(PG8_SA(1, 0), a3, voffA);
            PG8_WAIT_V(8); PG8_WAIT_L(0); PG8_BAR; PG8_MMA(1, 0, At, B0); PG8_MMA(1, 1, At, B1); PG8_BAR; PG8_SCHED;
        }
        if constexpr (ALIGN_EPI) { if (wr == 0) PG8_BAR; }
        E(acc, cur, wr, wc, fr, fq); S.done(cur);
        if (!has_next) break;
#pragma unroll
        for (int a = 0; a < 2; ++a)
#pragma unroll
            for (int b = 0; b < 2; ++b)
#pragma unroll
                for (int m = 0; m < 4; ++m)
#pragma unroll
                    for (int n = 0; n < 2; ++n) acc[a][b][m][n] = (f32x4){0.f, 0.f, 0.f, 0.f};
        cur = nxt; cA = nA; cB = nB; ++ui;
        if constexpr (ALIGN_EPI) { if (wr == 1) PG8_BAR; }
    }
    PG8_WAIT_V(0);
    if constexpr (!ALIGN_EPI) { if (wr == 0) PG8_BAR; }
    PG8_BAR;
#undef PG8_SA
#undef PG8_SB
#undef PG8_STAGE
#undef PG8_LDA
#undef PG8_LDB
#undef PG8_MMA
#undef PG8_WAIT_V
#undef PG8_WAIT_L
#undef PG8_BAR
#undef PG8_SCHED
}
}

#define XB_TMO      128
#define XB_XCNT(j)  (256  + 64 * (j))
#define XB_XSUB(j)  (1280 + 64 * (j))
#define XB_XGEN(j)  (2304 + 64 * (j))
#define XB_TOP      3328
#define XB_TOPGEN   3392
#define XCD_BAR_WORDS 3456
#define XB_SPIN_CAP (1u << 18)

__device__ __forceinline__ unsigned xb_ld(unsigned* p)              { return __hip_atomic_load(p, __ATOMIC_RELAXED, __HIP_MEMORY_SCOPE_AGENT); }
__device__ __forceinline__ unsigned xb_add(unsigned* p, unsigned v) { return __hip_atomic_fetch_add(p, v, __ATOMIC_RELAXED, __HIP_MEMORY_SCOPE_AGENT); }
__device__ __forceinline__ unsigned xb_xcc_id() { return (unsigned)__builtin_amdgcn_s_getreg((3 << 11) | 20) & 0xFu; }
#define XB_SPIN(cond, bar) do { unsigned _sp = 0; while (cond) { __builtin_amdgcn_s_sleep(1); \
    if ((++_sp & 255u) == 0u) { if (xb_ld(&(bar)[XB_TMO])) break; if (_sp > XB_SPIN_CAP) { atomicAdd(&(bar)[XB_TMO], 1u); break; } } } } while (0)

struct XcdBarrier { unsigned* bar; unsigned x; volatile LAS unsigned* st; };

__device__ __forceinline__ XcdBarrier xcd_barrier_post(unsigned* bar, volatile LAS unsigned* st) {
    XcdBarrier b; b.bar = bar; b.x = xb_xcc_id(); b.st = st;
    if (threadIdx.x == 0) (void)xb_add(&bar[XB_XCNT(b.x)], 1u);
    return b;
}
__device__ __forceinline__ void xcd_barrier_complete(unsigned* bar, unsigned x, unsigned& nloc, unsigned& nx) {
    const unsigned G = gridDim.x * gridDim.y * gridDim.z;
    unsigned sum, cnt, mine, sp = 0u;
    for (;;) {
        sum = 0u; cnt = 0u; mine = 0u;
#pragma unroll
        for (unsigned j = 0; j < 16; ++j) { const unsigned c = xb_ld(&bar[XB_XCNT(j)]); sum += c; cnt += (c > 0u) ? 1u : 0u; mine = (j == x) ? c : mine; }
        if (sum == G) break;
        __builtin_amdgcn_s_sleep(1);
        if ((++sp & 255u) == 0u) { if (xb_ld(&bar[XB_TMO])) break; if (sp > XB_SPIN_CAP) { atomicAdd(&bar[XB_TMO], 1u); break; } }
    }
    nloc = mine > 0u ? mine : 1u; nx = cnt > 0u ? cnt : 1u;
}
__device__ __forceinline__ void xcd_barrier(const XcdBarrier& b) {
    asm volatile("s_waitcnt vmcnt(0)" ::: "memory");
    __syncthreads();
    if (threadIdx.x == 0) {
        unsigned* bar = b.bar;
        __builtin_amdgcn_s_waitcnt(0);
        unsigned nloc = b.st[0], nx = b.st[1];
        if (nloc == 0u) { xcd_barrier_complete(bar, b.x, nloc, nx); b.st[0] = nloc; b.st[1] = nx; }
        const unsigned old = xb_add(&bar[XB_XSUB(b.x)], 1u);
        const unsigned gen = old / nloc;
        if (old + 1u == (gen + 1u) * nloc) {
            __builtin_amdgcn_fence(__ATOMIC_RELEASE, "agent");
            asm volatile("s_waitcnt vmcnt(0)" ::: "memory");
            const unsigned og = xb_add(&bar[XB_TOP], 1u);
            const unsigned tg = og / nx;
            if (og + 1u == (tg + 1u) * nx) xb_add(&bar[XB_TOPGEN], 1u);
            else XB_SPIN(xb_ld(&bar[XB_TOPGEN]) == tg, bar);
            __builtin_amdgcn_fence(__ATOMIC_ACQUIRE, "agent");
            xb_add(&bar[XB_XGEN(b.x)], 1u);
            asm volatile("s_waitcnt vmcnt(0)" ::: "memory");
        } else {
            XB_SPIN(xb_ld(&bar[XB_XGEN(b.x)]) == gen, bar);
            __builtin_amdgcn_fence(__ATOMIC_ACQUIRE, "agent");
            asm volatile("s_waitcnt vmcnt(0)" ::: "memory");
        }
    }
    __syncthreads();
}

struct Args { const float* in[30]; float* out; unsigned char* ws; int ph_lo, ph_hi; };
enum { I_X = 0, I_C, I_CTX, I_CCTX, I_ADAW, I_ADAB, I_NMG, I_NFG, I_WIN, I_MU, I_W0, I_W2, I_A0, I_A2, I_G2, I_KK, I_KA, I_RK, I_LNW, I_LNB, I_RPB, I_WOUT,
       I_FW1, I_FW3, I_FW2, I_ROUTER, I_MW1, I_MW3, I_MW2, I_FING };

__device__ __forceinline__ void transpose_item(const float* W, int K, int ldw, int ncols, bf16* WT, int mode, LAS float* scr, int item, int lane) {
    const int N = ldw; const int nblk = ncols / 32, kb = item / nblk, nb = item % nblk, k0 = 64 * kb, n0 = 32 * nb;
    { f32x4 v[8]; const int n4 = (lane & 7) * 4;
#pragma unroll
        for (int i = 0; i < 8; ++i) v[i] = *(const f32x4*)(W + (size_t)(k0 + 8 * i + (lane >> 3)) * N + n0 + n4);
#pragma unroll
        for (int i = 0; i < 8; ++i) { LAS float* d = scr + (8 * i + (lane >> 3)) * 33 + n4; d[0] = v[i].x; d[1] = v[i].y; d[2] = v[i].z; d[3] = v[i].w; } }
    asm volatile("s_waitcnt lgkmcnt(0)" ::: "memory");
    const int c = lane & 7;
    const int r0 = (mode == 0) ? n0 : (256 * (n0 >> 7) + (n0 & 127) + (mode == 2 ? 128 : 0));
#pragma unroll
    for (int j = 0; j < 4; ++j) { const int n = (lane >> 3) + 8 * j; const LAS float* s = scr + (8 * c) * 33 + n;
        v4u o; o.x = pk2(s[0 * 33], s[1 * 33]); o.y = pk2(s[2 * 33], s[3 * 33]); o.z = pk2(s[4 * 33], s[5 * 33]); o.w = pk2(s[6 * 33], s[7 * 33]);
        *(v4u*)(WT + (size_t)(r0 + n) * K + k0 + 8 * c) = o; }
    asm volatile("s_waitcnt lgkmcnt(0)" ::: "memory");
}
__device__ __forceinline__ void convert_matrix(const float* W, int K, int ldw, int ncols, bf16* WT, int mode, LAS float* scr, int& gw, int NGW, int lane) {
    const int nitems = (K / 64) * (ncols / 32);
    for (int it = gw; it < nitems; it += NGW) transpose_item(W, K, ldw, ncols, WT, mode, scr, it, lane);
    gw = (gw + NGW - nitems % NGW) % NGW;
}
constexpr int MOE_CONV_ITEMS = 24 * 16 * 112;
__device__ __forceinline__ void convert_moe_range(const Args& a, int i, unsigned char* lds, int it_lo, int it_hi, int cw, int ncw, int wave, int lane) {
    LAS float* scr = (LAS float*)((LAS unsigned char*)lds + wave * 16384);
    bf16* MUP = (bf16*)(a.ws + WS_MUP); bf16* MDN = (bf16*)(a.ws + WS_MDN);
    constexpr int IT = 16 * 112;
    for (int it = it_lo + cw; it < it_hi; it += ncw) {
        const int job = it / IT, r = it % IT, e = job / 3, w = job % 3;
        const size_t eoff = ((size_t)i * NEXP + e) * (size_t)D * DFFE;
        if (w == 0) transpose_item(a.in[I_MW1] + eoff, D, DFFE, DFFE, MUP + (size_t)e * 7168 * 1024, 1, scr, r, lane);
        else if (w == 1) transpose_item(a.in[I_MW3] + eoff, D, DFFE, DFFE, MUP + (size_t)e * 7168 * 1024, 2, scr, r, lane);
        else transpose_item(a.in[I_MW2] + eoff, DFFE, D, D, MDN + (size_t)e * 1024 * 3584, 0, scr, r, lane);
    }
}
__device__ __forceinline__ void prologue_phase(const Args& a, unsigned char* lds, int G) {
    const int tid = threadIdx.x, lane = tid & 63, wave = tid >> 6;
    int gw = blockIdx.x * NWAVES + wave; const int NGW = G * NWAVES;
    {
        LAS float* sc = (LAS float*)lds;
        LAS float* red = (LAS float*)lds + 17 * 1024;
        for (int i = tid; i < 17 * 1024; i += NTHR) { const int r = i >> 10, k = i & 1023; const float v = (r < 16) ? a.in[I_C][r * 1024 + k] : a.in[I_CCTX][k]; sc[i] = v * sigmoidf_(v); }
        __syncthreads();
        float* MODS = (float*)(a.ws + WS_MODS);
        for (int it = blockIdx.x; it < DEPTH * 48; it += G) {
            const int l = it / 48, cb = it % 48, cp = tid & 63, ks = tid >> 6;
            const float* w = a.in[I_ADAW] + (size_t)l * 1024 * MODW + cb * 128 + cp * 2;
            float acc[17][2];
#pragma unroll
            for (int r = 0; r < 17; ++r) { acc[r][0] = 0.f; acc[r][1] = 0.f; }
            for (int k0 = ks * 128; k0 < ks * 128 + 128; k0 += 16) {
                f32x2 wv[16];
#pragma unroll
                for (int u = 0; u < 16; ++u) wv[u] = *(const f32x2*)(w + (size_t)(k0 + u) * MODW);
                __builtin_amdgcn_sched_barrier(0);
#pragma unroll
                for (int u = 0; u < 16; ++u)
#pragma unroll
                    for (int r = 0; r < 17; ++r) { const float s = sc[r * 1024 + k0 + u]; acc[r][0] += s * wv[u].x; acc[r][1] += s * wv[u].y; } }
#pragma unroll
            for (int r = 0; r < 17; ++r) { red[(ks * 17 + r) * 128 + cp * 2] = acc[r][0]; red[(ks * 17 + r) * 128 + cp * 2 + 1] = acc[r][1]; }
            __syncthreads();
            for (int i = tid; i < 17 * 128; i += NTHR) { const int r = i >> 7, c = i & 127; float s = a.in[I_ADAB][l * MODW + cb * 128 + c];
#pragma unroll
                for (int q = 0; q < 8; ++q) s += red[(q * 17 + r) * 128 + c];
                MODS[((size_t)l * 17 + r) * MODW + cb * 128 + c] = s; }
            __syncthreads();
        }
    }
    __syncthreads();
    LAS float* scr = (LAS float*)((LAS unsigned char*)lds + wave * 16384);
    for (int l = 0; l < DEPTH; ++l) {
        bf16* win = (bf16*)(a.ws + WS_WIN) + (size_t)l * 3584 * 1024; const float* wsrc = a.in[I_WIN] + (size_t)l * D * DIN;
        convert_matrix(wsrc, D, DIN, 1024, win, 0, scr, gw, NGW, lane);
        convert_matrix(wsrc + 1536, D, DIN, 1920, win + (size_t)1024 * 1024, 0, scr, gw, NGW, lane);
        for (int i = gw * 64 + lane; i < 128 * 1024 / 8; i += NGW * 64) *(v4u*)(win + (size_t)2944 * 1024 + (size_t)i * 8) = (v4u){0u, 0u, 0u, 0u};
        convert_matrix(wsrc + 1024, D, DIN, 512, win + (size_t)3072 * 1024, 0, scr, gw, NGW, lane);
        convert_matrix(a.in[I_WOUT] + (size_t)l * D * D, D, D, D, (bf16*)(a.ws + WS_WOUT) + (size_t)l * D * D, 0, scr, gw, NGW, lane);
        convert_matrix(a.in[I_G2] + (size_t)l * 128 * DRW, 128, DRW, DRW, (bf16*)(a.ws + WS_G2T) + (size_t)l * DRW * 128, 0, scr, gw, NGW, lane);
    }
    for (int i = 0; i < 2; ++i) {
        bf16* wup = (bf16*)(a.ws + WS_WUP) + (size_t)i * 5632 * 1024;
        convert_matrix(a.in[I_FW1] + (size_t)i * D * DFF, D, DFF, DFF, wup, 1, scr, gw, NGW, lane);
        convert_matrix(a.in[I_FW3] + (size_t)i * D * DFF, D, DFF, DFF, wup, 2, scr, gw, NGW, lane);
        convert_matrix(a.in[I_FW2] + (size_t)i * DFF * D, DFF, D, D, (bf16*)(a.ws + WS_WDN) + (size_t)i * 1024 * DFF, 0, scr, gw, NGW, lane);
    }
}

__device__ __forceinline__ void row_modnorm_store(const f32x4 (&v)[4], const float* gain, const float* shift, const float* scale, bf16* hrow, int lane, f32x4 (&h)[4]) {
    float ss = 0.f;
#pragma unroll
    for (int j = 0; j < 4; ++j) ss += (v[j].x * v[j].x + v[j].y * v[j].y) + (v[j].z * v[j].z + v[j].w * v[j].w);
    const float rstd = rsqrtf(wave_sum(ss) * (1.f / D) + RMS_EPS);
#pragma unroll
    for (int j = 0; j < 4; ++j) { const int c = 4 * lane + 256 * j;
        const f32x4 g = *(const f32x4*)(gain + c), sh = *(const f32x4*)(shift + c), sc = *(const f32x4*)(scale + c);
        h[j] = (v[j] * rstd) * g * (sc + 1.f) + sh;
        v2u o; o.x = pk2(h[j].x, h[j].y); o.y = pk2(h[j].z, h[j].w);
        *(v2u*)(hrow + c) = o; }
}
template <bool SRCF32> __device__ __forceinline__ void row_load(const void* src_ctx, const void* src_lat, int row, int lane, f32x4 (&v)[4]) {
    const size_t off = row < NCTX ? (size_t)row * D : (size_t)(row - NCTX) * D; const void* base = row < NCTX ? src_ctx : src_lat;
#pragma unroll
    for (int j = 0; j < 4; ++j) { const int c = 4 * lane + 256 * j;
        if constexpr (SRCF32) v[j] = *(const f32x4*)((const float*)base + off + c);
        else { const v2u w = *(const v2u*)((const bf16*)base + off + c); v[j] = (f32x4){__uint_as_float(w.x << 16), __uint_as_float(w.x & 0xffff0000u), __uint_as_float(w.y << 16), __uint_as_float(w.y & 0xffff0000u)}; } }
}
__device__ __forceinline__ void row_store_xs(bf16* XS, int row, int c, const f32x4 v) { *(v2u*)(XS + (size_t)row * D + c) = (v2u){pg8::cvt_pk_bf16(v.x, v.y), pg8::cvt_pk_bf16(v.z, v.w)}; }
__device__ __forceinline__ int row_mrow(int row) { return row < NCTX ? 16 : ((row - NCTX) >> 11); }

template <int COMB  , bool SRCF32 = false>
__device__ __forceinline__ void norm_phase(const Args& a, const void* src_ctx, const void* src_lat, const float* gain, const float* mods_l, int m_shift, int m_scale,
                                           const float* mods_prev, int row_lo, int row_hi, int G) {
    const int tid = threadIdx.x, lane = tid & 63, wave = tid >> 6;
    const int gw = blockIdx.x * NWAVES + wave, NGW = G * NWAVES;
    bf16* H = (bf16*)(a.ws + WS_H); bf16* XS = (bf16*)(a.ws + WS_XS);
    const bf16* YS = (const bf16*)(a.ws + WS_YS); const unsigned* route = (const unsigned*)(a.ws + WS_ROUTE);
    constexpr int NR = 4;
    for (int row0 = row_lo + gw; row0 < row_hi; row0 += NR * NGW) {
        int rows[NR]; bool has[NR]; f32x4 v[NR][4], h[4];
#pragma unroll
        for (int r = 0; r < NR; ++r) { has[r] = row0 + r * NGW < row_hi; rows[r] = has[r] ? row0 + r * NGW : row0; }
#pragma unroll
        for (int r = 0; r < NR; ++r) row_load<SRCF32>(src_ctx, src_lat, rows[r], lane, v[r]);
        if (COMB == 3) { const bf16* DBa = (const bf16*)(a.ws + WS_DB2); const bf16* DBb = (const bf16*)(a.ws + WS_DB2B);
#pragma unroll
            for (int r = 0; r < NR; ++r) if (has[r] && rows[r] < NCTX) {
#pragma unroll
                for (int j = 0; j < 4; ++j) { const int c = 4 * lane + 256 * j; const v2u y0 = *(const v2u*)(DBa + (size_t)rows[r] * D + c), y1 = *(const v2u*)(DBb + (size_t)rows[r] * D + c);
                    v[r][j].x += bf2f(y0.x & 0xffffu) + bf2f(y1.x & 0xffffu); v[r][j].y += bf2f(y0.x >> 16) + bf2f(y1.x >> 16); v[r][j].z += bf2f(y0.y & 0xffffu) + bf2f(y1.y & 0xffffu); v[r][j].w += bf2f(y0.y >> 16) + bf2f(y1.y >> 16);
                    row_store_xs(XS, rows[r], c, v[r][j]); } }
        }
        if (COMB == 1) {
            unsigned s0[NR], s1[NR]; v2u y0[NR][4], y1[NR][4];
#pragma unroll
            for (int r = 0; r < NR; ++r) { s0[r] = route[(size_t)rows[r] * 8 + 6]; s1[r] = route[(size_t)rows[r] * 8 + 7]; }
#pragma unroll
            for (int r = 0; r < NR; ++r)
#pragma unroll
                for (int j = 0; j < 4; ++j) { const int c = 4 * lane + 256 * j; y0[r][j] = *(const v2u*)(YS + (size_t)s0[r] * D + c); y1[r][j] = *(const v2u*)(YS + (size_t)s1[r] * D + c); }
#pragma unroll
            for (int r = 0; r < NR; ++r) { const float* g5 = mods_prev + row_mrow(rows[r]) * MODW + 5 * D;
#pragma unroll
                for (int j = 0; j < 4; ++j) { const int c = 4 * lane + 256 * j; const f32x4 gg = *(const f32x4*)(g5 + c); const v2u ya = y0[r][j], yb = y1[r][j];
                    v[r][j].x += gg.x * (bf2f(ya.x & 0xffffu) + bf2f(yb.x & 0xffffu)); v[r][j].y += gg.y * (bf2f(ya.x >> 16) + bf2f(yb.x >> 16));
                    v[r][j].z += gg.z * (bf2f(ya.y & 0xffffu) + bf2f(yb.y & 0xffffu)); v[r][j].w += gg.w * (bf2f(ya.y >> 16) + bf2f(yb.y >> 16));
                    if (has[r]) row_store_xs(XS, rows[r], c, v[r][j]); } }
        }
#pragma unroll
        for (int r = 0; r < NR; ++r) if (has[r]) { const int mr = row_mrow(rows[r]);
            row_modnorm_store(v[r], gain, mods_l + mr * MODW + m_shift * D, mods_l + mr * MODW + m_scale * D, H + (size_t)rows[r] * D, lane, h); }
    }
}

__device__ __forceinline__ void norm_route_phase(const Args& a, const float* gain, const float* mods_l, const float* router, unsigned* cnt, int row_lo, int row_hi, unsigned char* lds, int G) {
    const int tid = threadIdx.x, lane = tid & 63, wave = tid >> 6;
    const int gw = blockIdx.x * NWAVES + wave, NGW = G * NWAVES;
    bf16* H = (bf16*)(a.ws + WS_H); const bf16* XS = (const bf16*)(a.ws + WS_XS); unsigned* route = (unsigned*)(a.ws + WS_ROUTE);
    LAS unsigned* lcnt = (LAS unsigned*)((LAS unsigned char*)lds + 32768);
    LAS float* rt = (LAS float*)lds;
    for (int i = tid; i < 1024 * 8; i += NTHR) { const int c = i >> 3, e = i & 7; rt[(e >> 2) * 4096 + (((c >> 8) * 4 + (c & 3)) * 64 + ((c & 255) >> 2)) * 4 + (e & 3)] = router[i]; }
    if (tid < 16) lcnt[tid] = 0u;
    __syncthreads();
    constexpr int NR = 4;
    for (int row0 = row_lo + gw; row0 < row_hi; row0 += NR * NGW) {
        int rows[NR]; bool has[NR]; f32x4 vv[NR][4];
#pragma unroll
        for (int r = 0; r < NR; ++r) { has[r] = row0 + r * NGW < row_hi; rows[r] = has[r] ? row0 + r * NGW : row0; }
#pragma unroll
        for (int r = 0; r < NR; ++r) row_load<false>(XS, XS + (size_t)NCTX * D, rows[r], lane, vv[r]);
#pragma unroll
        for (int r = 0; r < NR; ++r) if (has[r]) { const int row = rows[r];
            const int mr = row_mrow(row);
            f32x4 h[4];
            row_modnorm_store(vv[r], gain, mods_l + mr * MODW + 3 * D, mods_l + mr * MODW + 4 * D, H + (size_t)row * D, lane, h);
            float lg[8];
#pragma unroll
            for (int e = 0; e < 8; ++e) lg[e] = 0.f;
#pragma unroll
            for (int j = 0; j < 4; ++j)
#pragma unroll
                for (int i = 0; i < 4; ++i) { const f32x4 r0 = *(const LAS f32x4*)(rt + ((j * 4 + i) * 64 + lane) * 4), r1 = *(const LAS f32x4*)(rt + 4096 + ((j * 4 + i) * 64 + lane) * 4); const float hv = h[j][i];
                    lg[0] += hv * r0.x; lg[1] += hv * r0.y; lg[2] += hv * r0.z; lg[3] += hv * r0.w; lg[4] += hv * r1.x; lg[5] += hv * r1.y; lg[6] += hv * r1.z; lg[7] += hv * r1.w; }
#pragma unroll
            for (int e = 0; e < 8; ++e) lg[e] = wave_sum(lg[e]);
            int e0 = 0; float l0 = lg[0];
#pragma unroll
            for (int e = 1; e < 8; ++e) if (lg[e] > l0) { l0 = lg[e]; e0 = e; }
            int e1 = -1; float l1 = -3.0e38f;
#pragma unroll
            for (int e = 0; e < 8; ++e) if (e != e0 && lg[e] > l1) { l1 = lg[e]; e1 = e; }
            if (lane == 0) {
                const float g0 = 1.f / (1.f + __expf(l1 - l0)), g1 = 1.f - g0;
                const unsigned p0 = __hip_atomic_fetch_add(&lcnt[e0], 1u, __ATOMIC_RELAXED, __HIP_MEMORY_SCOPE_WORKGROUP), p1 = __hip_atomic_fetch_add(&lcnt[e1], 1u, __ATOMIC_RELAXED, __HIP_MEMORY_SCOPE_WORKGROUP);
                unsigned* rr = route + (size_t)row * 8;
                rr[0] = (unsigned)e0; rr[1] = (unsigned)e1; rr[2] = p0; rr[3] = p1; rr[4] = __float_as_uint(g0); rr[5] = __float_as_uint(g1);
            }
        }
    }
    __syncthreads();
    if (tid < 8) lcnt[8 + tid] = atomicAdd(cnt + tid * 64, lcnt[tid]);
    __syncthreads();
    for (int row = row_lo + gw; row < row_hi; row += NGW) {
        if (lane == 0) { unsigned* r = route + (size_t)row * 8; r[2] += lcnt[8 + r[0]]; r[3] += lcnt[8 + r[1]]; }
    }
}

__device__ __forceinline__ void moe_ranges(const unsigned* cnt, LAS unsigned* tab) {
    if (threadIdx.x == 0) { unsigned s = 0;
        for (int e = 0; e < 8; ++e) { const unsigned c = __hip_atomic_load(cnt + e * 64, __ATOMIC_RELAXED, __HIP_MEMORY_SCOPE_AGENT); tab[e] = s; tab[16 + e] = c; s += (c + 255u) & ~255u; tab[8 + e] = s; } }
    __syncthreads();
}

__device__ __forceinline__ void moe_fill_list(LAS int* list, int nwg, int G, int c, int nd) {
    const int i = threadIdx.x;
    if (i < 64) { long Lx;
        if (nd == 0) Lx = (long)i * G + c;
        else if (c < nd) Lx = (long)(i + 1) * G + c;
        else { const int r = (nwg - c + G - 1) / G;
            if (i < r) Lx = (long)i * G + c; else { const long j = (long)(c - nd) + (long)(i - r) * (G - nd); Lx = j < nd ? j : nwg; } }
        list[i] = Lx < nwg ? (int)Lx : nwg; }
}

__device__ __forceinline__ void gather_phase(const Args& a, const unsigned* cnt, int row_lo, int row_hi, unsigned char* lds, int G) {
    const int tid = threadIdx.x, lane = tid & 63, wave = tid >> 6;
    const int gw = blockIdx.x * NWAVES + wave, NGW = G * NWAVES;
    LAS unsigned* tab = (LAS unsigned*)lds;
    moe_ranges(cnt, tab);
    const bf16* H = (const bf16*)(a.ws + WS_H); bf16* XG = (bf16*)(a.ws + WS_XG); float* slotg = (float*)(a.ws + WS_SLOTG); unsigned* route = (unsigned*)(a.ws + WS_ROUTE);
    constexpr int NR = 4;
    for (int row0 = row_lo + gw; row0 < row_hi; row0 += NR * NGW) {
        int rows[NR]; bool has[NR]; v4u q[NR], x0[NR], x1[NR]; v2u g[NR];
#pragma unroll
        for (int r = 0; r < NR; ++r) { has[r] = row0 + r * NGW < row_hi; rows[r] = has[r] ? row0 + r * NGW : row0; }
#pragma unroll
        for (int r = 0; r < NR; ++r) { const unsigned* rr = route + (size_t)rows[r] * 8; q[r] = *(const v4u*)rr; g[r] = *(const v2u*)(rr + 4);
            const v4u* s = (const v4u*)(H + (size_t)rows[r] * D); x0[r] = s[lane]; x1[r] = s[64 + lane]; }
#pragma unroll
        for (int r = 0; r < NR; ++r) if (has[r]) { unsigned* rr = route + (size_t)rows[r] * 8;
            const unsigned s0 = tab[q[r].x] + q[r].z, s1 = tab[q[r].y] + q[r].w;
            if (lane == 0) { rr[6] = s0; rr[7] = s1; slotg[s0] = __uint_as_float(g[r].x); slotg[s1] = __uint_as_float(g[r].y); }
            v4u* d0 = (v4u*)(XG + (size_t)s0 * D); v4u* d1 = (v4u*)(XG + (size_t)s1 * D); d0[lane] = x0[r]; d0[64 + lane] = x1[r]; d1[lane] = x0[r]; d1[64 + lane] = x1[r]; }
    }
    for (int e = 0; e < 8; ++e) {
        const unsigned p0 = tab[e] + tab[16 + e], p1 = tab[8 + e];
        for (unsigned s = p0 + gw; s < p1; s += NGW) { v4u* d = (v4u*)(XG + (size_t)s * D); d[lane] = (v4u){0u, 0u, 0u, 0u}; d[64 + lane] = (v4u){0u, 0u, 0u, 0u}; if (lane == 0) slotg[s] = 0.f; }
    }
}

__device__ __forceinline__ float p_shift(const bf16* P, int row, int t, int Tlen, int pcol, float mu) {
    const float pc = bf2f(P[(size_t)row * DINP + pcol]);
    const float pm = t > 0 ? bf2f(P[(size_t)(row - 1) * DINP + pcol]) : 0.f;
    const float pn = t < Tlen - 1 ? bf2f(P[(size_t)(row + 1) * DINP + pcol]) : 0.f;
    return pc + mu * (0.5f * (pm + pn) - pc);
}

template <int CTRL> __device__ __forceinline__ float dpp_f(float x) { return __int_as_float(__builtin_amdgcn_update_dpp(0, __float_as_int(x), CTRL, 0xF, 0xF, true)); }
__device__ __forceinline__ float red16(float x) {
    x += dpp_f<0xB1>(x);
    x += dpp_f<0x4E>(x);
    x += dpp_f<0x141>(x);
    x += dpp_f<0x140>(x);
    return x;
}
__device__ __forceinline__ float fast_tanh(float x) { return 1.f - 2.f * __builtin_amdgcn_rcpf(1.f + __expf(2.f * x)); }

__device__ __forceinline__ pg8::bf16x8 frag4(const LAS bf16* p) { const v2u x = *(const LAS v2u*)p; return __builtin_bit_cast(pg8::bf16x8, (v4u){x.x, x.y, 0u, 0u}); }
__device__ __forceinline__ pg8::bf16x8 frag44(const LAS bf16* p, const LAS bf16* q) { const v2u x = *(const LAS v2u*)p, y = *(const LAS v2u*)q; return __builtin_bit_cast(pg8::bf16x8, (v4u){x.x, x.y, y.x, y.y}); }
__device__ __forceinline__ pg8::bf16x8 pack4(const f32x4 a) { return __builtin_bit_cast(pg8::bf16x8, (v4u){pg8::cvt_pk_bf16(a[0], a[1]), pg8::cvt_pk_bf16(a[2], a[3]), 0u, 0u}); }
__device__ __forceinline__ pg8::bf16x8 pack44(const f32x4 a, const f32x4 b) { return __builtin_bit_cast(pg8::bf16x8, (v4u){pg8::cvt_pk_bf16(a[0], a[1]), pg8::cvt_pk_bf16(a[2], a[3]), pg8::cvt_pk_bf16(b[0], b[1]), pg8::cvt_pk_bf16(b[2], b[3])}); }
__device__ __forceinline__ void shift8r(const v4u xc, const v4u xm, const v4u xn, const LAS float* mu8, f32x4& u0, f32x4& u1) {
    const f32x4 m0 = *(const LAS f32x4*)(mu8), m1 = *(const LAS f32x4*)(mu8 + 4);
#define S8_ONE(dst, k_, wsel, mm) { const float pc_ = bf2f(xc.wsel & 0xffffu), pm_ = bf2f(xm.wsel & 0xffffu), pn_ = bf2f(xn.wsel & 0xffffu); dst[k_] = pc_ + mm[k_] * ((pm_ + pn_) * 0.5f - pc_); \
      const float qc_ = __uint_as_float(xc.wsel & 0xffff0000u), qm_ = __uint_as_float(xm.wsel & 0xffff0000u), qn_ = __uint_as_float(xn.wsel & 0xffff0000u); dst[k_ + 1] = qc_ + mm[k_ + 1] * ((qm_ + qn_) * 0.5f - qc_); }
    S8_ONE(u0, 0, x, m0) S8_ONE(u0, 2, y, m0) S8_ONE(u1, 0, z, m1) S8_ONE(u1, 2, w, m1)
#undef S8_ONE
}

__device__ __forceinline__ bf16 hw_bf16(float x) { return (bf16)(pg8::cvt_pk_bf16(x, x) & 0xffffu); }
__device__ __forceinline__ void scan_phase(const Args& a, int l, bool last, unsigned char* lds, int G) {
    typedef pg8::bf16x8 bf16x8;
    const int tid = threadIdx.x;
    const bf16* P = (const bf16*)(a.ws + WS_P); float* YD = (float*)(a.ws + WS_YD); float* SB = (float*)(a.ws + WS_SB);
    LAS unsigned char* L = (LAS unsigned char*)lds;
    LAS bf16* W2b = (LAS bf16*)(L);
    LAS bf16* A2b = (LAS bf16*)(L + 9216);
    LAS float* vec = (LAS float*)(L + 18432);
    LAS float* w0s = vec, *a0s = vec + 64, *kks = vec + 128, *kas = vec + 192, *rks = vec + 256, *mus = vec + 320;
    LAS float* Zs = (LAS float*)(L + 21248);
    volatile LAS int* done = (volatile LAS int*)(L + 37632);
    LAS v4u* SF = (LAS v4u*)(L + 121664);
    for (int chain = blockIdx.x; chain < 256; chain += G) {
        const int b = chain >> 4, h = (chain >> 1) & 7, d = chain & 1;
        __syncthreads();
        for (int i = tid; i < 4096; i += NTHR) { const int r = i >> 6, c = i & 63;
            W2b[c * 72 + r] = (bf16)f2bf(a.in[I_W2][(((size_t)l * 2 + d) * 64 + r) * DRW + h * 64 + c]);
            A2b[c * 72 + r] = (bf16)f2bf(a.in[I_A2][(((size_t)l * 2 + d) * 64 + r) * DRW + h * 64 + c]); }
        if (tid < 64) { const int c = h * 64 + tid;
            w0s[tid] = a.in[I_W0][(l * 2 + d) * DRW + c]; a0s[tid] = a.in[I_A0][(l * 2 + d) * DRW + c];
            kks[tid] = a.in[I_KK][l * DRW + c]; kas[tid] = a.in[I_KA][l * DRW + c]; rks[tid] = a.in[I_RK][l * DRW + c]; }
        if (tid < 320) { const int j = tid; const int ucol = j < 64 ? h * 64 + j : j < 128 ? 512 + h * 64 + (j - 64) : j < 192 ? 1024 + h * 64 + (j - 128) : j < 256 ? 1536 + d * 64 + (j - 192) : 1664 + d * 64 + (j - 256);
            mus[j] = a.in[I_MU][l * DSHIFT + ucol]; }
        for (int i = tid; i < 4096; i += NTHR) Zs[i] = 0.f;
        for (int i = tid; i < 24 * 64; i += NTHR) { const int f = i >> 6, ln = i & 63, arr = f >> 3, nt = (f >> 1) & 3, kind = f & 1, fr_ = ln & 15, fq_ = ln >> 4;
            unsigned hb = 0u;
            if (fq_ == 2 * (nt & 1) + (fr_ >> 3)) { const float mu = a.in[I_MU][l * DSHIFT + arr * 512 + h * 64 + 16 * nt + fr_]; hb = f2bf(kind ? 0.5f * mu : 1.f - mu) << (16 * (fr_ & 1)); }
            const int ds = (fr_ & 7) >> 1;
            SF[i] = (v4u){ds == 0 ? hb : 0u, ds == 1 ? hb : 0u, ds == 2 ? hb : 0u, ds == 3 ? hb : 0u}; }
        if (tid < 4) done[tid] = 0;
        __syncthreads();
        const int wv = __builtin_amdgcn_readfirstlane(tid >> 6);
        LAS unsigned char* Wp = L + 37696 + wv * 10496;
        LAS bf16* X = (LAS bf16*)Wp;
        LAS bf16* Qt = X, *Rt = X + 1152, *Kt = X + 2304, *Bt = X + 3456;
        LAS bf16* Tm = X + 2304, *Ak = Tm + 384, *Gk = Ak + 384, *Gb = Gk + 384;
        LAS float* Ab = (LAS float*)(Wp + 9216);
        LAS float* gCs = (LAS float*)(Wp + 10240);
        for (int n = wv; n < 144; n += 8) {
            int lane = tid & 63; asm volatile("" : "+v"(lane));
            const int fr = lane & 15, fq = lane >> 4;
            const bool isctx = n < 16; const int Tlen = isctx ? CTXL : SEQ, rowbase = isctx ? b * CTXL : NCTX + b * SEQ, cn = isctx ? n : n - 16;
#define T_OF(i_) (d ? Tlen - 1 - (16 * cn + (i_)) : 16 * cn + (i_))
            const int tA = T_OF(fr); const bool hm = tA > 0, hn = tA < Tlen - 1;
            const bf16* prow = P + (size_t)(rowbase + tA) * DINP + URW;
            const bf16* zrow = (const bf16*)(a.ws + WS_CTL + 512 * 1024);
            const bf16* prm = hm ? prow - DINP : zrow; const bf16* prn = hn ? prow + DINP : zrow;
            v4u lw[2][3], la[2][3], xr[3][2][3];
#pragma unroll
            for (int ks = 0; ks < 2; ++ks) { const int cw = 1536 + d * 64 + 32 * ks + 8 * fq, ca = 1664 + d * 64 + 32 * ks + 8 * fq;
                lw[ks][0] = *(const v4u*)(prow + cw); lw[ks][1] = *(const v4u*)(prm + cw); lw[ks][2] = *(const v4u*)(prn + cw);
                la[ks][0] = *(const v4u*)(prow + ca); la[ks][1] = *(const v4u*)(prm + ca); la[ks][2] = *(const v4u*)(prn + ca); }
#pragma unroll
            for (int arr = 0; arr < 3; ++arr)
#pragma unroll
                for (int ks = 0; ks < 2; ++ks) { const int co = arr * 512 + h * 64 + 32 * ks + 8 * fq;
                    xr[arr][ks][0] = *(const v4u*)(prow + co); xr[arr][ks][1] = *(const v4u*)(prm + co); xr[arr][ks][2] = *(const v4u*)(prn + co); }
            bf16x8 fa_w[2], fa_a[2];
#pragma unroll
            for (int ks = 0; ks < 2; ++ks) { f32x4 u0, u1;
                shift8r(lw[ks][0], lw[ks][1], lw[ks][2], mus + 192 + 32 * ks + 8 * fq, u0, u1);
                fa_w[ks] = __builtin_bit_cast(bf16x8, (v4u){pg8::cvt_pk_bf16(fast_tanh(u0[0]), fast_tanh(u0[1])), pg8::cvt_pk_bf16(fast_tanh(u0[2]), fast_tanh(u0[3])), pg8::cvt_pk_bf16(fast_tanh(u1[0]), fast_tanh(u1[1])), pg8::cvt_pk_bf16(fast_tanh(u1[2]), fast_tanh(u1[3]))});
                shift8r(la[ks][0], la[ks][1], la[ks][2], mus + 256 + 32 * ks + 8 * fq, u0, u1);
                fa_a[ks] = __builtin_bit_cast(bf16x8, (v4u){pg8::cvt_pk_bf16(u0[0], u0[1]), pg8::cvt_pk_bf16(u0[2], u0[3]), pg8::cvt_pk_bf16(u1[0], u1[1]), pg8::cvt_pk_bf16(u1[2], u1[3])}); }
            f32x4 rrv[4], kxv[4], vvv[4];
#define SHIFT_ARR(arr_, dst_) \
            _Pragma("unroll") for (int ks = 0; ks < 2; ++ks) { \
                const bf16x8 fc = __builtin_bit_cast(bf16x8, xr[arr_][ks][0]), fm = __builtin_bit_cast(bf16x8, xr[arr_][ks][1]), fn = __builtin_bit_cast(bf16x8, xr[arr_][ks][2]); \
                _Pragma("unroll") for (int q = 0; q < 2; ++q) { const int nt = 2 * ks + q; \
                    const bf16x8 bc = __builtin_bit_cast(bf16x8, SF[(((arr_) * 4 + nt) * 2 + 0) * 64 + lane]), bn = __builtin_bit_cast(bf16x8, SF[(((arr_) * 4 + nt) * 2 + 1) * 64 + lane]); \
                    f32x4 acc = {0.f, 0.f, 0.f, 0.f}; \
                    acc = __builtin_amdgcn_mfma_f32_16x16x32_bf16(fc, bc, acc, 0, 0, 0); acc = __builtin_amdgcn_mfma_f32_16x16x32_bf16(fm, bn, acc, 0, 0, 0); acc = __builtin_amdgcn_mfma_f32_16x16x32_bf16(fn, bn, acc, 0, 0, 0); \
                    dst_[nt] = acc; } }
            SHIFT_ARR(0, rrv) SHIFT_ARR(1, kxv) SHIFT_ARR(2, vvv)
#undef SHIFT_ARR
            f32x4 accw[4], acca[4];
#pragma unroll
            for (int nt = 0; nt < 4; ++nt) { accw[nt] = (f32x4){0.f, 0.f, 0.f, 0.f}; acca[nt] = (f32x4){0.f, 0.f, 0.f, 0.f};
#pragma unroll
                for (int ks = 0; ks < 2; ++ks) {
                    accw[nt] = __builtin_amdgcn_mfma_f32_16x16x32_bf16(fa_w[ks], *(const LAS bf16x8*)(W2b + (16 * nt + fr) * 72 + 32 * ks + 8 * fq), accw[nt], 0, 0, 0);
                    acca[nt] = __builtin_amdgcn_mfma_f32_16x16x32_bf16(fa_a[ks], *(const LAS bf16x8*)(A2b + (16 * nt + fr) * 72 + 32 * ks + 8 * fq), acca[nt], 0, 0, 0); } }
            f32x4 kkv[4], bbv[4], kdv[4], cu[4];
            float n2[4] = {0.f, 0.f, 0.f, 0.f}, sb[4] = {0.f, 0.f, 0.f, 0.f};
#pragma unroll
            for (int nt = 0; nt < 4; ++nt) { const int c = 16 * nt + fr; const float w0c = w0s[c], a0c = a0s[c], kkc = kks[c], kac = kas[c], rkc = rks[c];
#pragma unroll
                for (int e = 0; e < 4; ++e) {
                    const float rr = rrv[nt][e], kx = kxv[nt][e];
                    const float ew = 0.60653065971f * sigmoidf_(w0c + accw[nt][e]);
                    const float av = sigmoidf_(a0c + acca[nt][e]);
                    const float kraw = kx * kkc, kd = kx * (1.f + (av - 1.f) * kac);
                    n2[e] += kraw * kraw; sb[e] += rr * kd * rkc;
                    kkv[nt][e] = kraw; bbv[nt][e] = av; kdv[nt][e] = kd; cu[nt][e] = ew; } }
            float inv[4];
#pragma unroll
            for (int e = 0; e < 4; ++e) { inv[e] = __builtin_amdgcn_rsqf(fmaxf(red16(n2[e]), 1e-24f)); sb[e] = red16(sb[e]); }
            f32x4 qv[4], rv[4], kv[4], bv[4], khv[4], bhv[4];
#pragma unroll
            for (int nt = 0; nt < 4; ++nt) {
                const float p0 = cu[nt][0], p1 = p0 + cu[nt][1], p2 = p1 + cu[nt][2], p3 = p2 + cu[nt][3];
                float t1 = __shfl_up(p3, 16); if (fq < 1) t1 = 0.f; const float s1 = p3 + t1;
                float t2 = __shfl_up(s1, 32); if (fq < 2) t2 = 0.f; const float incl = s1 + t2, excl = incl - p3;
                const float cC = __shfl(incl, 48 + fr);
                const float cuv[4] = {excl + p0, excl + p1, excl + p2, excl + p3}, cpv[4] = {excl, excl + p0, excl + p1, excl + p2};
                const float gCv = __expf(-cC);
                float enp = __expf(-excl);
                (void)cpv;
#pragma unroll
                for (int e = 0; e < 4; ++e) { const float kk = kkv[nt][e] * inv[e], bb = kk * bbv[nt][e];
                    const float eu = __expf(cuv[e]), en = __builtin_amdgcn_rcpf(eu), ep = enp, eh = eu * gCv;
                    enp = en;
                    qv[nt][e] = kk * ep; rv[nt][e] = rrv[nt][e] * en; kv[nt][e] = kdv[nt][e] * eu; bv[nt][e] = bb * eu; khv[nt][e] = kdv[nt][e] * eh; bhv[nt][e] = -bb * eh; }
                if (fq == 3) gCs[16 * nt + fr] = gCv;
            }
#pragma unroll
            for (int nt = 0; nt < 4; ++nt)
#pragma unroll
                for (int e = 0; e < 4; ++e) { const int o = (4 * fq + e) * 72 + 16 * nt + fr;
                    Qt[o] = hw_bf16(qv[nt][e]); Rt[o] = hw_bf16(rv[nt][e]); Kt[o] = hw_bf16(kv[nt][e]); Bt[o] = hw_bf16(bv[nt][e]); }
            f32x4 m4[4], abt;
            { const LAS bf16* pq = Qt + fr * 72 + 8 * fq; const LAS bf16* pr = Rt + fr * 72 + 8 * fq; const LAS bf16* pk = Kt + fr * 72 + 8 * fq; const LAS bf16* pb = Bt + fr * 72 + 8 * fq;
                const bf16x8 q0 = *(const LAS bf16x8*)pq, q1 = *(const LAS bf16x8*)(pq + 32), r0f = *(const LAS bf16x8*)pr, r1f = *(const LAS bf16x8*)(pr + 32);
                const bf16x8 k0 = *(const LAS bf16x8*)pk, k1 = *(const LAS bf16x8*)(pk + 32), b0 = *(const LAS bf16x8*)pb, b1 = *(const LAS bf16x8*)(pb + 32);
                const f32x4 zero = {0.f, 0.f, 0.f, 0.f};
                m4[0] = __builtin_amdgcn_mfma_f32_16x16x32_bf16(q1, b1, __builtin_amdgcn_mfma_f32_16x16x32_bf16(q0, b0, zero, 0, 0, 0), 0, 0, 0);
                abt   = __builtin_amdgcn_mfma_f32_16x16x32_bf16(b1, q1, __builtin_amdgcn_mfma_f32_16x16x32_bf16(b0, q0, zero, 0, 0, 0), 0, 0, 0);
                m4[1] = __builtin_amdgcn_mfma_f32_16x16x32_bf16(q1, k1, __builtin_amdgcn_mfma_f32_16x16x32_bf16(q0, k0, zero, 0, 0, 0), 0, 0, 0);
                m4[2] = __builtin_amdgcn_mfma_f32_16x16x32_bf16(r1f, k1, __builtin_amdgcn_mfma_f32_16x16x32_bf16(r0f, k0, zero, 0, 0, 0), 0, 0, 0);
                m4[3] = __builtin_amdgcn_mfma_f32_16x16x32_bf16(r1f, b1, __builtin_amdgcn_mfma_f32_16x16x32_bf16(r0f, b0, zero, 0, 0, 0), 0, 0, 0); }
            f32x4 nn, nt, idv;
#pragma unroll
            for (int e = 0; e < 4; ++e) { const int t = 4 * fq + e;
                m4[1][e] = (fr < t) ? m4[1][e] : 0.f; m4[2][e] = (fr <= t) ? m4[2][e] : 0.f; m4[3][e] = (fr <= t) ? m4[3][e] : 0.f;
                nn[e] = (fr < t) ? -m4[0][e] : 0.f; nt[e] = (t < fr) ? -abt[e] : 0.f; idv[e] = (t == fr) ? 1.f : 0.f; }
#pragma unroll
            for (int e = 0; e < 4; ++e) { const int t = 4 * fq + e; Ak[t * 24 + fr] = hw_bf16(m4[1][e]); Gk[t * 24 + fr] = hw_bf16(m4[2][e]); Gb[t * 24 + fr] = hw_bf16(-m4[3][e]); }
            bf16x8 TF;
            { const f32x4 zero = {0.f, 0.f, 0.f, 0.f};
                const bf16x8 pn = pack4(nn), pnt = pack4(nt);
                const f32x4 n2 = __builtin_amdgcn_mfma_f32_16x16x32_bf16(pnt, pn, zero, 0, 0, 0), n2t = __builtin_amdgcn_mfma_f32_16x16x32_bf16(pn, pnt, zero, 0, 0, 0);
                const bf16x8 p2 = pack4(n2), p2t = pack4(n2t);
                const f32x4 n4 = __builtin_amdgcn_mfma_f32_16x16x32_bf16(p2t, p2, zero, 0, 0, 0), n4t = __builtin_amdgcn_mfma_f32_16x16x32_bf16(p2, p2t, zero, 0, 0, 0);
                const f32x4 n8t = __builtin_amdgcn_mfma_f32_16x16x32_bf16(pack4(n4), pack4(n4t), zero, 0, 0, 0);
                const f32x4 ra = __builtin_amdgcn_mfma_f32_16x16x32_bf16(pack4(n4 + idv), pack4(n8t + idv), zero, 0, 0, 0);
                const f32x4 rb2 = __builtin_amdgcn_mfma_f32_16x16x32_bf16(pack4(n2 + idv), pack4(ra), zero, 0, 0, 0);
                const f32x4 tt = __builtin_amdgcn_mfma_f32_16x16x32_bf16(pack4(nn + idv), pack4(rb2), zero, 0, 0, 0);
                TF = pack4(tt); }
            bf16x8 Vb[4], KBF[4];
#pragma unroll
            for (int nt = 0; nt < 4; ++nt) { Vb[nt] = pack4(vvv[nt]); KBF[nt] = pack44(khv[nt], bhv[nt]); }
            const bf16x8 AkF = frag4(Ak + fr * 24 + 4 * fq), GkbF = frag44(Gk + fr * 24 + 4 * fq, Gb + fr * 24 + 4 * fq);
            f32x4 AkV[4];
            { const f32x4 zero = {0.f, 0.f, 0.f, 0.f};
#pragma unroll
                for (int sl = 0; sl < 4; ++sl) AkV[sl] = __builtin_amdgcn_mfma_f32_16x16x32_bf16(AkF, Vb[sl], zero, 0, 0, 0); }
            const bf16x8 Qf0 = frag44(Qt + fr * 72 + 4 * fq, Qt + fr * 72 + 16 + 4 * fq), Qf1 = frag44(Qt + fr * 72 + 32 + 4 * fq, Qt + fr * 72 + 48 + 4 * fq);
            const bf16x8 Rf0 = frag44(Rt + fr * 72 + 4 * fq, Rt + fr * 72 + 16 + 4 * fq), Rf1 = frag44(Rt + fr * 72 + 32 + 4 * fq, Rt + fr * 72 + 48 + 4 * fq);
            f32x4 g4[4];
#pragma unroll
            for (int zt = 0; zt < 4; ++zt) g4[zt] = *(const LAS f32x4*)(gCs + 16 * zt + 4 * fq);
#pragma unroll
            for (int zt = 0; zt < 4; ++zt) asm volatile("" : "+v"(KBF[zt]));
            f32x4 Yo[4];
#pragma unroll
            for (int sl = 0; sl < 4; ++sl) {
                while (done[sl] != n) __builtin_amdgcn_s_sleep(1);
                asm volatile("" ::: "memory");
                const f32x4 zero = {0.f, 0.f, 0.f, 0.f};
                f32x4 z[4];
#pragma unroll
                for (int zt = 0; zt < 4; ++zt) z[zt] = *(const LAS f32x4*)(Zs + ((zt * 4 + sl) * 64 + lane) * 4);
                const bf16x8 zb0 = pack44(z[0], z[1]), zb1 = pack44(z[2], z[3]);
                f32x4 w = __builtin_amdgcn_mfma_f32_16x16x32_bf16(Qf0, zb0, AkV[sl], 0, 0, 0);
                w = __builtin_amdgcn_mfma_f32_16x16x32_bf16(Qf1, zb1, w, 0, 0, 0);
                const f32x4 uu = __builtin_amdgcn_mfma_f32_16x16x32_bf16(TF, pack4(w), zero, 0, 0, 0);
                const v4u vb = __builtin_bit_cast(v4u, Vb[sl]);
                const bf16x8 ub = __builtin_bit_cast(bf16x8, (v4u){vb.x, vb.y, pg8::cvt_pk_bf16(uu[0], uu[1]), pg8::cvt_pk_bf16(uu[2], uu[3])});
#pragma unroll
                for (int zt = 0; zt < 4; ++zt) *(LAS f32x4*)(Zs + ((zt * 4 + sl) * 64 + lane) * 4) = __builtin_amdgcn_mfma_f32_16x16x32_bf16(KBF[zt], ub, g4[zt] * z[zt], 0, 0, 0);
                asm volatile("s_waitcnt lgkmcnt(0)" ::: "memory");
                if (lane == 0) done[sl] = n + 1;
                f32x4 y = __builtin_amdgcn_mfma_f32_16x16x32_bf16(Rf0, zb0, zero, 0, 0, 0);
                y = __builtin_amdgcn_mfma_f32_16x16x32_bf16(Rf1, zb1, y, 0, 0, 0);
                Yo[sl] = __builtin_amdgcn_mfma_f32_16x16x32_bf16(GkbF, ub, y, 0, 0, 0);
            }
            if (!(last && isctx)) {
#pragma unroll
                for (int e = 0; e < 4; ++e) { const int t = T_OF(4 * fq + e); bf16* yr = (bf16*)YD + ((size_t)d * NTOK + rowbase + t) * DRW + h * 64 + 4 * fr;
                    *(v2u*)yr = (v2u){pg8::cvt_pk_bf16(Yo[0][e], Yo[1][e]), pg8::cvt_pk_bf16(Yo[2][e], Yo[3][e])};
                    if (fr == 0) SB[((size_t)d * NTOK + rowbase + t) * 8 + h] = sb[e]; }
            }
#undef T_OF
        }
    }
}

__device__ __forceinline__ void readout_phase(const Args& a, int l, int row_lo, int row_hi, unsigned char* lds, int G) {
    typedef pg8::bf16x8 bf16x8;
    const int tid0 = threadIdx.x, wv = __builtin_amdgcn_readfirstlane(tid0 >> 6), h = wv;
    const bf16* P = (const bf16*)(a.ws + WS_P); const float* YD = (const float*)(a.ws + WS_YD); const float* SB = (const float*)(a.ws + WS_SB); bf16* YCAT = (bf16*)(a.ws + WS_YCAT);
    const bf16* g2t = (const bf16*)(a.ws + WS_G2T) + (size_t)l * DRW * 128; const bf16* YDb = (const bf16*)YD;
    LAS unsigned char* L = (LAS unsigned char*)lds;
    LAS bf16* Pg = (LAS bf16*)L;
    LAS bf16* Pv = (LAS bf16*)(L + 4896);
    LAS bf16* SGb = (LAS bf16*)(L + 4896 + 18720);
    LAS bf16* Ot = (LAS bf16*)(L + 4896 + 18720 + 4352);
    const float* mu = a.in[I_MU] + l * DSHIFT;
    bf16x8 bfr[4][4]; float lnw[4], lnb[4], muv[4];
    { const int lane = tid0 & 63, fr = lane & 15, fq = lane >> 4;
#pragma unroll
        for (int nt = 0; nt < 4; ++nt) { const int c = 64 * h + 16 * nt + fr; lnw[nt] = a.in[I_LNW][l * DRW + c]; lnb[nt] = a.in[I_LNB][l * DRW + c]; muv[nt] = mu[1024 + c];
#pragma unroll
            for (int ks = 0; ks < 4; ++ks) bfr[nt][ks] = *(const bf16x8*)(g2t + (size_t)c * 128 + 32 * ks + 8 * fq); } }
    const int nblk = (row_hi - row_lo) / 16;
    v4u xa[3];
#define RO_LOADA(blk_, tid_) { const int R0_ = row_lo + (blk_) * 16; const int t0_ = R0_ < NCTX ? (R0_ & 255) : ((R0_ - NCTX) & 2047), Tlen_ = R0_ < NCTX ? CTXL : SEQ; \
        _Pragma("unroll") for (int q = 0; q < 3; ++q) { const int pc = (tid_) + 512 * q; v4u x = {0u, 0u, 0u, 0u}; \
            if (pc < 1440 && (blk_) < nblk) { const int rr = pc / 80, sg = pc % 80, t = t0_ - 1 + rr; const int col = sg < 16 ? URW + 1792 + sg * 8 : URW + 1024 + (sg - 16) * 8; \
                if (t >= 0 && t < Tlen_) x = *(const v4u*)(P + (size_t)(R0_ - 1 + rr) * DINP + col); } \
            xa[q] = x; } }
    RO_LOADA((int)blockIdx.x, tid0)
    for (int blk = blockIdx.x; blk < nblk; blk += G) {
        int tid = tid0; asm volatile("" : "+v"(tid));
        const int lane = tid & 63, fr = lane & 15, fq = lane >> 4;
        const int R0 = row_lo + blk * 16;
        float ya[4][4], yb[4][4], sba[4], sbb[4];
#pragma unroll
        for (int e = 0; e < 4; ++e) { const int row = R0 + 4 * fq + e;
            { const v2u wa = *(const v2u*)(YDb + (size_t)row * DRW + 64 * h + 4 * fr), wb = *(const v2u*)(YDb + ((size_t)NTOK + row) * DRW + 64 * h + 4 * fr);
                ya[e][0] = bf2f(wa.x & 0xffffu); ya[e][1] = bf2f(wa.x >> 16); ya[e][2] = bf2f(wa.y & 0xffffu); ya[e][3] = bf2f(wa.y >> 16);
                yb[e][0] = bf2f(wb.x & 0xffffu); yb[e][1] = bf2f(wb.x >> 16); yb[e][2] = bf2f(wb.y & 0xffffu); yb[e][3] = bf2f(wb.y >> 16); }
            sba[e] = SB[(size_t)row * 8 + h]; sbb[e] = SB[((size_t)NTOK + row) * 8 + h]; }
        __syncthreads();
#pragma unroll
        for (int q = 0; q < 3; ++q) { const int pc = tid + 512 * q;
            if (pc < 1440) { const int rr = pc / 80, sg = pc % 80;
                if (sg < 16) *(LAS v4u*)(Pg + rr * 136 + sg * 8) = xa[q]; else *(LAS v4u*)(Pv + rr * 520 + (sg - 16) * 8) = xa[q]; } }
        RO_LOADA(blk + G, tid)
        __syncthreads();
        { const int i = tid >> 5, r4 = (tid & 31) * 4;
            const v2u wc = *(const LAS v2u*)(Pg + (i + 1) * 136 + r4), wm = *(const LAS v2u*)(Pg + i * 136 + r4), wn = *(const LAS v2u*)(Pg + (i + 2) * 136 + r4);
            const f32x4 m4 = *(const f32x4*)(mu + 1792 + r4);
            const f32x4 pc = {bf2f(wc.x & 0xffffu), bf2f(wc.x >> 16), bf2f(wc.y & 0xffffu), bf2f(wc.y >> 16)}, pm = {bf2f(wm.x & 0xffffu), bf2f(wm.x >> 16), bf2f(wm.y & 0xffffu), bf2f(wm.y >> 16)},
                        pn = {bf2f(wn.x & 0xffffu), bf2f(wn.x >> 16), bf2f(wn.y & 0xffffu), bf2f(wn.y >> 16)};
            const f32x4 u = pc + m4 * ((pm + pn) * 0.5f - pc);
            *(LAS v2u*)(SGb + i * 136 + r4) = (v2u){pg8::cvt_pk_bf16(sigmoidf_(u.x), sigmoidf_(u.y)), pg8::cvt_pk_bf16(sigmoidf_(u.z), sigmoidf_(u.w))}; }
        __syncthreads();
        f32x4 g[4];
#pragma unroll
        for (int nt = 0; nt < 4; ++nt) g[nt] = (f32x4){0.f, 0.f, 0.f, 0.f};
#pragma unroll
        for (int ks = 0; ks < 4; ++ks) { const bf16x8 af = *(const LAS bf16x8*)(SGb + fr * 136 + 32 * ks + 8 * fq);
#pragma unroll
            for (int nt = 0; nt < 4; ++nt) g[nt] = __builtin_amdgcn_mfma_f32_16x16x32_bf16(af, bfr[nt][ks], g[nt], 0, 0, 0); }
#pragma unroll
        for (int e = 0; e < 4; ++e) { const int i = 4 * fq + e;
            float y[4], s1 = 0.f;
#pragma unroll
            for (int nt = 0; nt < 4; ++nt) { y[nt] = ya[e][nt] + yb[e][nt]; s1 += y[nt]; }
            const float mean = red16(s1) * (1.f / 64.f); float s2 = 0.f;
#pragma unroll
            for (int nt = 0; nt < 4; ++nt) { y[nt] -= mean; s2 += y[nt] * y[nt]; }
            const float rstd = rsqrtf(red16(s2) * (1.f / 64.f) + GN_EPS);
            const float sbv = 0.5f * (sba[e] + sbb[e]);
#pragma unroll
            for (int nt = 0; nt < 4; ++nt) { const int c = 64 * h + 16 * nt + fr;
                const float pc = bf2f(Pv[(i + 1) * 520 + c]), pm = bf2f(Pv[i * 520 + c]), pn = bf2f(Pv[(i + 2) * 520 + c]);
                const float vs = pc + muv[nt] * (0.5f * (pm + pn) - pc);
                Ot[i * 520 + c] = (bf16)f2bf((y[nt] * rstd * lnw[nt] + lnb[nt] + sbv * vs) * g[nt][e]); } }
        __syncthreads();
#pragma unroll
        for (int q = 0; q < 2; ++q) { const int pc = tid + 512 * q, i = pc >> 6, sg = pc & 63;
            *(v4u*)(YCAT + (size_t)(R0 + i) * D + sg * 8) = *(const LAS v4u*)(Ot + i * 520 + sg * 8); }
    }
#undef RO_LOADA
}

template <bool LOCAL>
__device__ __forceinline__ void na_unit(const bf16* P, const bf16* VT, bf16* YCAT, const LAS float* rpb_l, LAS bf16* buf, int b, int gr, int hp, int qblk, int tid) {
    typedef pg8::bf16x8 bf16x8;
    constexpr int NCH = LOCAL ? 12 : 4, NLOC = LOCAL ? 8 : 0;
    const int lane = tid & 63, wv = tid >> 6, fr = lane & 15, fq = lane >> 4, hh = wv >> 2, qb = wv & 3, h = 2 * hp + hh;
    const int qrow0 = LOCAL ? NCTX + b * SEQ + gr * 64 + 16 * qb : b * CTXL + qblk * 64 + 16 * qb;
    const int r0 = min(max(gr - 4, 0), 24);
    const int kc0 = qb == 0 ? 0 : qb == 1 ? 8 : qb == 2 ? 24 : 32;
    const int qcol = 16 * qb + fr, cs = min(max(qcol - 8, 0), 48);
    const LAS float* rpb = rpb_l + h * 15 * 31;
    v4u ld[2][2];
    const int lrow = (tid >> 3) & 63, lseg = tid & 7;
#define NA_TOKBASE(c) ((LOCAL && (c) < 8) ? NCTX + b * SEQ + (r0 + (c)) * 64 : b * CTXL + ((c) - NLOC) * 64)
#define NA_ISSUE(sidx) do { const int c_ = (sidx) % NCH; const int tb_ = NA_TOKBASE(c_); _Pragma("unroll") for (int q_ = 0; q_ < 2; ++q_) { \
        if ((sidx) < NCH) ld[(sidx) & 1][q_] = *(const v4u*)(P + (size_t)(tb_ + lrow) * DINP + 512 + (2 * hp + q_) * 64 + lseg * 8); \
        else ld[(sidx) & 1][q_] = *(const v4u*)(VT + (size_t)((2 * hp + q_) * 64 + lrow) * NTOK + tb_ + lseg * 8); } } while (0)
#define NA_STORE(sidx) do { LAS bf16* d_ = buf + ((sidx) & 1) * 9216; _Pragma("unroll") for (int q_ = 0; q_ < 2; ++q_) *(LAS v4u*)(d_ + q_ * 4608 + lrow * 72 + lseg * 8) = ld[(sidx) & 1][q_]; } while (0)
    bf16x8 qf[2];
#pragma unroll
    for (int ks = 0; ks < 2; ++ks) qf[ks] = *(const bf16x8*)(P + (size_t)(qrow0 + fr) * DINP + h * 64 + 32 * ks + 8 * fq);
    f32x4 sl[16], sc[16];
    float m = -1.0e30f, lsum = 0.f;
    f32x4 o[4];
#pragma unroll
    for (int dt = 0; dt < 4; ++dt) o[dt] = (f32x4){0.f, 0.f, 0.f, 0.f};
    NA_ISSUE(0); NA_ISSUE(1); NA_STORE(0);
    __syncthreads();
#pragma unroll
    for (int sidx = 0; sidx < 2 * NCH; ++sidx) {
        if (sidx + 2 < 2 * NCH) NA_ISSUE(sidx + 2);
        const LAS bf16* cb = buf + (sidx & 1) * 9216 + hh * 4608;
        if (sidx < NCH) {
            const int c = sidx;
            if (LOCAL && c < 8) {
#pragma unroll
                for (int t2 = 0; t2 < 2; ++t2) {
                    const LAS bf16* kp = cb + (kc0 + 16 * t2 + fr) * 72 + 8 * fq;
                    f32x4 acc = {0.f, 0.f, 0.f, 0.f};
                    acc = __builtin_amdgcn_mfma_f32_16x16x32_bf16(*(const LAS bf16x8*)(kp), qf[0], acc, 0, 0, 0);
                    acc = __builtin_amdgcn_mfma_f32_16x16x32_bf16(*(const LAS bf16x8*)(kp + 32), qf[1], acc, 0, 0, 0);
                    const LAS float* rb = rpb + (r0 + c - gr + 7) * 31 + 15 - qcol;
#pragma unroll
                    for (int e = 0; e < 4; ++e) { const int kcol = kc0 + 16 * t2 + 4 * fq + e; const bool ok = (kcol >= cs) && (kcol < cs + 16);
                        const float sv = ok ? acc[e] * 0.125f + rb[ok ? kcol : qcol] : -1.0e30f; acc[e] = sv; m = fmaxf(m, sv); }
                    sl[2 * (c < 8 ? c : 0) + t2] = acc; }
            } else {
                const int cc = c - NLOC;
#pragma unroll
                for (int t4 = 0; t4 < 4; ++t4) {
                    const LAS bf16* kp = cb + (16 * t4 + fr) * 72 + 8 * fq;
                    f32x4 acc = {0.f, 0.f, 0.f, 0.f};
                    acc = __builtin_amdgcn_mfma_f32_16x16x32_bf16(*(const LAS bf16x8*)(kp), qf[0], acc, 0, 0, 0);
                    acc = __builtin_amdgcn_mfma_f32_16x16x32_bf16(*(const LAS bf16x8*)(kp + 32), qf[1], acc, 0, 0, 0);
#pragma unroll
                    for (int e = 0; e < 4; ++e) { acc[e] *= 0.125f; m = fmaxf(m, acc[e]); }
                    sc[4 * (cc >= 0 ? cc : 0) + t4] = acc; }
            }
            if (sidx == NCH - 1) { m = fmaxf(m, __shfl_xor(m, 16)); m = fmaxf(m, __shfl_xor(m, 32)); }
        } else {
            const int c = sidx - NCH;
            if (LOCAL && c < 8) {
                float p[8];
#pragma unroll
                for (int e = 0; e < 4; ++e) { p[e] = __expf(sl[2 * (c < 8 ? c : 0)][e] - m); p[4 + e] = __expf(sl[2 * (c < 8 ? c : 0) + 1][e] - m); }
#pragma unroll
                for (int e = 0; e < 8; ++e) lsum += p[e];
                const bf16x8 pf = __builtin_bit_cast(bf16x8, (v4u){pg8::cvt_pk_bf16(p[0], p[1]), pg8::cvt_pk_bf16(p[2], p[3]), pg8::cvt_pk_bf16(p[4], p[5]), pg8::cvt_pk_bf16(p[6], p[7])});
#pragma unroll
                for (int dt = 0; dt < 4; ++dt) { const LAS bf16* vp = cb + (16 * dt + fr) * 72 + kc0 + 4 * fq;
                    o[dt] = __builtin_amdgcn_mfma_f32_16x16x32_bf16(frag44(vp, vp + 16), pf, o[dt], 0, 0, 0); }
            } else {
                const int cc = c - NLOC;
#pragma unroll
                for (int p2 = 0; p2 < 2; ++p2) {
                    float p[8];
#pragma unroll
                    for (int e = 0; e < 4; ++e) { p[e] = __expf(sc[4 * (cc >= 0 ? cc : 0) + 2 * p2][e] - m); p[4 + e] = __expf(sc[4 * (cc >= 0 ? cc : 0) + 2 * p2 + 1][e] - m); }
#pragma unroll
                    for (int e = 0; e < 8; ++e) lsum += p[e];
                    const bf16x8 pf = __builtin_bit_cast(bf16x8, (v4u){pg8::cvt_pk_bf16(p[0], p[1]), pg8::cvt_pk_bf16(p[2], p[3]), pg8::cvt_pk_bf16(p[4], p[5]), pg8::cvt_pk_bf16(p[6], p[7])});
#pragma unroll
                    for (int dt = 0; dt < 4; ++dt) { const LAS bf16* vp = cb + (16 * dt + fr) * 72 + 32 * p2 + 4 * fq;
                        o[dt] = __builtin_amdgcn_mfma_f32_16x16x32_bf16(frag44(vp, vp + 16), pf, o[dt], 0, 0, 0); }
                }
            }
        }
        if (sidx + 1 < 2 * NCH) NA_STORE(sidx + 1);
        __syncthreads();
    }
#undef NA_TOKBASE
#undef NA_ISSUE
#undef NA_STORE
    lsum += __shfl_xor(lsum, 16); lsum += __shfl_xor(lsum, 32);
    const float inv = 1.f / lsum;
    bf16* op = YCAT + (size_t)(qrow0 + fr) * D + 512 + h * 64 + 4 * fq;
#pragma unroll
    for (int dt = 0; dt < 4; ++dt) { v2u w; w.x = pg8::cvt_pk_bf16(o[dt][0] * inv, o[dt][1] * inv); w.y = pg8::cvt_pk_bf16(o[dt][2] * inv, o[dt][3] * inv); *(v2u*)(op + dt * 16) = w; }
}
__device__ __forceinline__ void na_phase(const Args& a, int l, bool last, unsigned char* lds, int G) {
    const bf16* P = (const bf16*)(a.ws + WS_P); const bf16* VT = (const bf16*)(a.ws + WS_VT); bf16* YCAT = (bf16*)(a.ws + WS_YCAT);
    LAS bf16* buf = (LAS bf16*)((LAS unsigned char*)lds);
    LAS float* rpb_l = (LAS float*)((LAS unsigned char*)lds + 36864);
    __syncthreads();
    for (int i = threadIdx.x; i < NH * 15 * 31; i += NTHR) rpb_l[i] = a.in[I_RPB][(size_t)l * NH * 15 * 31 + i];
    const int nunits = 2048 + (last ? 0 : 256);
    const int per_x = (nunits + 7) / 8, xcd = blockIdx.x & 7, slot = blockIdx.x >> 3, nslot = (G + 7) / 8;
    const bool xord = (G % 8 == 0);
    for (int it = 0;; ++it) {
        int u;
        if (xord) { const int off = slot + it * nslot; if (off >= per_x) break; u = xcd * per_x + off; if (u >= nunits) continue; }
        else { u = blockIdx.x + it * G; if (u >= nunits) break; }
        int tid = threadIdx.x; asm volatile("" : "+v"(tid));
        __syncthreads();
        if (u < 2048) na_unit<true>(P, VT, YCAT, rpb_l, buf, u >> 7, (u >> 2) & 31, u & 3, 0, tid);
        else { const int u2 = u - 2048; na_unit<false>(P, VT, YCAT, rpb_l, buf, u2 >> 4, 0, (u2 >> 2) & 3, u2 & 3, tid); }
    }
}

__device__ __forceinline__ void final_phase(const Args& a, const float* mods_prev, int G) {
    const int tid = threadIdx.x, lane = tid & 63, wave = tid >> 6;
    const int gw = blockIdx.x * NWAVES + wave, NGW = G * NWAVES;
    const bf16* XS = (const bf16*)(a.ws + WS_XS); const bf16* YS = (const bf16*)(a.ws + WS_YS); const unsigned* route = (const unsigned*)(a.ws + WS_ROUTE);
    const float* fg = a.in[I_FING];
    constexpr int NR = 4;
    for (int row0 = NCTX + gw; row0 < NTOK; row0 += NR * NGW) {
        int rows[NR]; bool has[NR]; unsigned s0[NR], s1[NR]; f32x4 vv[NR][4]; v2u y0[NR][4], y1[NR][4];
#pragma unroll
        for (int r = 0; r < NR; ++r) { has[r] = row0 + r * NGW < NTOK; rows[r] = has[r] ? row0 + r * NGW : row0; s0[r] = route[(size_t)rows[r] * 8 + 6]; s1[r] = route[(size_t)rows[r] * 8 + 7]; }
#pragma unroll
        for (int r = 0; r < NR; ++r) row_load<false>(XS, XS + (size_t)NCTX * D, rows[r], lane, vv[r]);
#pragma unroll
        for (int r = 0; r < NR; ++r)
#pragma unroll
            for (int j = 0; j < 4; ++j) { const int c = 4 * lane + 256 * j; y0[r][j] = *(const v2u*)(YS + (size_t)s0[r] * D + c); y1[r][j] = *(const v2u*)(YS + (size_t)s1[r] * D + c); }
#pragma unroll
        for (int r = 0; r < NR; ++r) if (has[r]) { const int row = rows[r];
            const float* g5 = mods_prev + row_mrow(row) * MODW + 5 * D; float ss = 0.f;
#pragma unroll
            for (int j = 0; j < 4; ++j) { const int c = 4 * lane + 256 * j; const f32x4 gg = *(const f32x4*)(g5 + c); f32x4& v = vv[r][j]; const v2u ya = y0[r][j], yb = y1[r][j];
                v.x += gg.x * (bf2f(ya.x & 0xffffu) + bf2f(yb.x & 0xffffu)); v.y += gg.y * (bf2f(ya.x >> 16) + bf2f(yb.x >> 16));
                v.z += gg.z * (bf2f(ya.y & 0xffffu) + bf2f(yb.y & 0xffffu)); v.w += gg.w * (bf2f(ya.y >> 16) + bf2f(yb.y >> 16));
                ss += (v.x * v.x + v.y * v.y) + (v.z * v.z + v.w * v.w); }
            const float rstd = rsqrtf(wave_sum(ss) * (1.f / D) + RMS_EPS);
#pragma unroll
            for (int j = 0; j < 4; ++j) { const int c = 4 * lane + 256 * j; const f32x4 g = *(const f32x4*)(fg + c);
                *(f32x4*)(a.out + (size_t)(row - NCTX) * D + c) = vv[r][j] * rstd * g; }
        }
    }
}

constexpr int NPL = 17;
constexpr int NPHASES = 1 + DEPTH * NPL + 1;
__host__ __device__ constexpr bool phase_active(int p) {
    if (p == 0 || p == NPHASES - 1) return true;
    const int l = (p - 1) / NPL, k = (p - 1) % NPL;
    return (l & 1) ? (k <= 7 + MOE_NGROUPS) : (k <= 7);
}

#define PH(p) if (lo <= (p) && (p) < hi)
#define PH_END(p) do { if ((p) + 1 < hi) xcd_barrier(bar); } while (0)
template <int l>
__device__ __forceinline__ void layer_body(const Args& args, unsigned char* lds, const XcdBarrier& bar, int G, int lo, int hi) {
    {
        constexpr int pb = 1 + l * NPL;
        if (pb + NPL <= lo || pb >= hi) return;
        unsigned* ctl = (unsigned*)(args.ws + WS_CTL);
        const float* MODS = (const float*)(args.ws + WS_MODS);
        bf16* XS = (bf16*)(args.ws + WS_XS);
        LAS unsigned char* L = (LAS unsigned char*)lds;
        constexpr bool last = (l == DEPTH - 1), moe = (l & 1);
        const float* mods_l = MODS + (size_t)l * 17 * MODW;
        const void* src_ctx = (l == 0) ? (const void*)args.in[I_CTX] : (const void*)XS;
        const void* src_lat = (l == 0) ? (const void*)args.in[I_X] : (const void*)(XS + (size_t)NCTX * D);
        const int flo = last ? NCTX : 0, ftile0 = last ? 16 : 0, fntile = last ? 128 : 144;
        unsigned* cnt = ctl + CW_CNT + (l >> 1) * 512;
        constexpr int NCONV = 32, CONV_N1 = 256 * MK_CONV_A, CONV_N2 = CONV_N1 + 256 * MK_CONV_B;
        constexpr int CONV_T1r = CONV_N2 + 96 * 8 * MK_CONV_C, CONV_T1 = CONV_T1r < MOE_CONV_ITEMS ? CONV_T1r : MOE_CONV_ITEMS;
        constexpr int CONV_T2r = CONV_T1 + 160 * 8 * MK_CONV_D, CONV_T2 = CONV_T2r < MOE_CONV_ITEMS ? CONV_T2r : MOE_CONV_ITEMS;
        constexpr int CONV_T3r = CONV_T2 + 128 * 8 * MK_CONV_E, CONV_T3 = CONV_T3r < MOE_CONV_ITEMS ? CONV_T3r : MOE_CONV_ITEMS;
        const int wave_ = (int)(threadIdx.x >> 6), lane_ = (int)(threadIdx.x & 63);
        const bool deleg = (G == 256) && !moe;
        const int GC = deleg ? G - NCONV : G;
        const bool convwg = deleg && (int)blockIdx.x >= GC;
        const int cwave = ((int)blockIdx.x - GC) * NWAVES + (int)(threadIdx.x >> 6);

        PH(pb + 0) {
            if (l == 2) norm_phase<1>(args, src_ctx, src_lat, args.in[I_NMG] + l * D, mods_l, 0, 1, MODS + (size_t)(l - 1) * 17 * MODW, 0, NTOK, G);
            else if (l == 0) norm_phase<0, true>(args, src_ctx, src_lat, args.in[I_NMG] + l * D, mods_l, 0, 1, nullptr, 0, NTOK, G);
            else norm_phase<3>(args, src_ctx, src_lat, args.in[I_NMG] + l * D, mods_l, 0, 1, nullptr, 0, NTOK, G);
            if (moe) convert_moe_range(args, l >> 1, lds, (G == 256) ? CONV_T3 : 0, MOE_CONV_ITEMS, blockIdx.x * NWAVES + (threadIdx.x >> 6), G * NWAVES, threadIdx.x >> 6, threadIdx.x & 63);
            PH_END(pb + 0); }
        PH(pb + 1) {
            if (convwg) convert_moe_range(args, l >> 1, lds, 0, CONV_N1, cwave, NCONV * NWAVES, threadIdx.x >> 6, threadIdx.x & 63);
            else {
            pg8::SchedIn S{GC, (int)blockIdx.x, (const char*)(args.ws + WS_H), (const char*)(args.ws + WS_WIN + (size_t)l * 3584 * 1024 * 2)};
            pg8::EpiIn E{(bf16*)(args.ws + WS_P), (bf16*)(args.ws + WS_VT)};
            pg8::gemm_phase<pg8::EpiIn, pg8::SchedIn>(L, 1024, S, E); }
            PH_END(pb + 1); }
        PH(pb + 2) { scan_phase(args, l, last, lds, G); PH_END(pb + 2); }
        PH(pb + 3) { if (blockIdx.x & 8) { na_phase(args, l, last, lds, G); __syncthreads(); readout_phase(args, l, flo, NTOK, lds, G); } else { readout_phase(args, l, flo, NTOK, lds, G); __syncthreads(); na_phase(args, l, last, lds, G); } PH_END(pb + 3); }
        PH(pb + 4) {
            if (convwg) convert_moe_range(args, l >> 1, lds, CONV_N1, CONV_N2, cwave, NCONV * NWAVES, threadIdx.x >> 6, threadIdx.x & 63);
            else {
            pg8::SchedS S; S.init(args.ws + WS_YCAT, args.ws + WS_WOUT + (size_t)l * D * D * 2, 1024, ftile0, fntile, 4, GC, (int)blockIdx.x);
            pg8::EpiRes<l == 0> E{XS, src_ctx, src_lat, mods_l, 2 * D};
            pg8::gemm_phase<pg8::EpiRes<l == 0>, pg8::SchedS>(L, 1024, S, E);
            if (deleg && (int)blockIdx.x >= 128) convert_moe_range(args, l >> 1, lds, CONV_N2, CONV_T1, ((int)blockIdx.x - 128) * NWAVES + wave_, 96 * NWAVES, wave_, lane_); }
            PH_END(pb + 4); }
        PH(pb + 5) {
            if (moe) norm_route_phase(args, args.in[I_NFG] + l * D, mods_l, args.in[I_ROUTER] + (size_t)(l >> 1) * D * NEXP, cnt, flo, NTOK, lds, G);
            else norm_phase<0>(args, XS, XS + (size_t)NCTX * D, args.in[I_NFG] + l * D, mods_l, 3, 4, nullptr, flo, NTOK, G);
            PH_END(pb + 5); }
        if (!moe) {
            PH(pb + 6) {
                pg8::SchedS S; S.init(args.ws + WS_H, args.ws + WS_WUP + (size_t)(l >> 1) * 5632 * 1024 * 2, 1024, ftile0, fntile, 22, G, (int)blockIdx.x);
                pg8::EpiSwi E{(bf16*)(args.ws + WS_T), DFF, 0};
                pg8::gemm_phase<pg8::EpiSwi, pg8::SchedS>(L, 1024, S, E);
                if (deleg && (int)blockIdx.x >= 96) convert_moe_range(args, l >> 1, lds, CONV_T1, CONV_T2, ((int)blockIdx.x - 96) * NWAVES + wave_, 160 * NWAVES, wave_, lane_);
                PH_END(pb + 6); }
            PH(pb + 7) {
                pg8::SchedS S; S.init(args.ws + WS_T, args.ws + WS_WDN + (size_t)(l >> 1) * 1024 * DFF * 2, DFF, 16, 128, 4, G, (int)blockIdx.x);
                pg8::EpiRes<false> E{XS, XS, XS + (size_t)NCTX * D, mods_l, 5 * D};
                pg8::gemm_phase<pg8::EpiRes<false>, pg8::SchedS>(L, DFF, S, E);
                __syncthreads();
                pg8::SchedK2 S2; S2.init(args.ws + WS_T, args.ws + WS_WDN + (size_t)(l >> 1) * 1024 * DFF * 2, DFF, 0, 16, 8, G, (int)blockIdx.x); S2.khb = (DFF / 2) * 2;
                pg8::EpiDelta E2{(bf16*)(args.ws + WS_DB2), (size_t)(WS_DB2B - WS_DB2) / 2, mods_l, 5 * D};
                pg8::gemm_phase<pg8::EpiDelta, pg8::SchedK2>(L, DFF / 2, S2, E2, DFF);
                if (deleg && (int)blockIdx.x >= 128) convert_moe_range(args, l >> 1, lds, CONV_T2, CONV_T3, ((int)blockIdx.x - 128) * NWAVES + wave_, 128 * NWAVES, wave_, lane_);
                PH_END(pb + 7); }
        } else {
            PH(pb + 6) { gather_phase(args, cnt, flo, NTOK, lds, G); PH_END(pb + 6); }
            for (int k = 0; k <= MOE_NGROUPS; ++k) {
                PH(pb + 7 + k) {
                    __syncthreads();
                    LAS unsigned* tab = (LAS unsigned*)((LAS unsigned char*)lds + 131072);
                    moe_ranges(cnt, tab);
                    pg8::SchedE S; const int nused = (int)(tab[15] >> 8);
#pragma unroll
                    for (int e = 0; e < 8; ++e) S.tend[e] = (int)(tab[8 + e] >> 8);
#define MOE_T0(g_) ((g_) == 0 ? (MOE_NGROUPS - 1) * MOE_GROUP : ((g_) - 1) * MOE_GROUP)
                    LAS int* list0 = (LAS int*)(tab + 32); LAS int* list1 = (LAS int*)(tab + 96);
                    {
                        int nMd = 0, nMu = 0;
                        if (k >= 1) { nMd = nused - MOE_T0(k - 1); nMd = nMd > MOE_GROUP ? MOE_GROUP : (nMd < 0 ? 0 : nMd); }
                        if (k < MOE_NGROUPS) { nMu = nused - MOE_T0(k); nMu = nMu > MOE_GROUP ? MOE_GROUP : (nMu < 0 ? 0 : nMu); }
                        const int ndn = nMd * 4, nup = nMu * 28;
                        moe_fill_list(list0, ndn, G, (int)blockIdx.x, 0);
                        moe_fill_list(list1, nup, G, (int)blockIdx.x, (ndn > 0 && ndn < G && nup >= 2 * G) ? ndn : 0);
                        __syncthreads(); }
                    if (k >= 1) { const int g = k - 1, t0 = MOE_T0(g); int nM = nused - t0; nM = nM > MOE_GROUP ? MOE_GROUP : nM;
                        S.init(args.ws + WS_TM + (size_t)(g & 1) * 112 * MiB, args.ws + WS_MDN, DFFE, t0, nM, 4, G, (int)blockIdx.x); S.asub = t0; S.bes = (size_t)1024 * 3584 * 2; S.list = list0;
                        pg8::EpiMoeDn E{(bf16*)(args.ws + WS_YS), (const float*)(args.ws + WS_SLOTG)};
                        pg8::gemm_phase<pg8::EpiMoeDn, pg8::SchedE>(L, DFFE, S, E);
                        __syncthreads(); }
                    if (k < MOE_NGROUPS) { const int g = k, t0 = MOE_T0(g); int nM = nused - t0; nM = nM > MOE_GROUP ? MOE_GROUP : nM;
                        S.init(args.ws + WS_XG, args.ws + WS_MUP, 1024, t0, nM, 28, G, (int)blockIdx.x); S.asub = 0; S.bes = (size_t)7168 * 1024 * 2;
                        S.list = list1;
                        pg8::EpiSwi E{(bf16*)(args.ws + WS_TM + (size_t)(g & 1) * 112 * MiB), DFFE, t0};
                        pg8::gemm_phase<pg8::EpiSwi, pg8::SchedE>(L, 1024, S, E); }
#undef MOE_T0
                    PH_END(pb + 7 + k); }
            }
        }
    }
}

__global__ void __launch_bounds__(NTHR, 2) mk_fwd(Args args) {
    extern __shared__ __attribute__((aligned(16))) unsigned char lds[];
    const int G = gridDim.x, lo = args.ph_lo, hi = args.ph_hi;
    volatile LAS unsigned* xbw = (volatile LAS unsigned*)((LAS unsigned char*)lds + LDS_BYTES - 64);
    if (threadIdx.x < 4) xbw[threadIdx.x] = 0u;
    __syncthreads();
    unsigned* ctl = (unsigned*)(args.ws + WS_CTL);
    XcdBarrier bar; bar.bar = ctl + CW_BAR; bar.x = 0; bar.st = xbw;
    if (hi - lo > 1) bar = xcd_barrier_post(ctl + CW_BAR, xbw);
    const float* MODS = (const float*)(args.ws + WS_MODS);
    LAS unsigned char* L = (LAS unsigned char*)lds;

    PH(0) { prologue_phase(args, lds, G); PH_END(0); }

    layer_body<0>(args, lds, bar, G, lo, hi);
    layer_body<1>(args, lds, bar, G, lo, hi);
    layer_body<2>(args, lds, bar, G, lo, hi);
    layer_body<3>(args, lds, bar, G, lo, hi);
    PH(NPHASES - 1) { final_phase(args, MODS + (size_t)(DEPTH - 1) * 17 * MODW, G); }
#undef PH
#undef PH_END
}

extern "C" void kernel_launch(void* const* d_in, const int* in_sizes, int n_in, void* d_out, int out_size, void* d_ws, size_t ws_size, hipStream_t stream) {
    static int grid = 0;
    if (grid == 0) {
        if (n_in != 30 || out_size != NLAT * D || ws_size < WS_END) { fprintf(stderr, "kernel_launch: unexpected shapes (n_in %d out %d ws %zu)\n", n_in, out_size, ws_size); grid = -1; return; }
        int dev = 0, cus = 0;
        if (hipGetDevice(&dev) != hipSuccess || hipDeviceGetAttribute(&cus, hipDeviceAttributeMultiprocessorCount, dev) != hipSuccess) { grid = -1; return; }
        if (hipFuncSetAttribute((const void*)mk_fwd, hipFuncAttributeMaxDynamicSharedMemorySize, LDS_BYTES) != hipSuccess) { grid = -1; return; }
        int per_cu = 0;
        if (hipOccupancyMaxActiveBlocksPerMultiprocessor(&per_cu, (const void*)mk_fwd, NTHR, LDS_BYTES) != hipSuccess || per_cu < 1) { fprintf(stderr, "kernel_launch: occupancy query says %d\n", per_cu); }
        (void)hipGetLastError();
        grid = cus > 0 ? cus : 256;
    }
    if (grid < 0) return;
    (void)hipMemsetAsync((char*)d_ws + WS_CTL, 0, CTL_BYTES, stream);
    Args a{};
    for (int i = 0; i < 30; ++i) a.in[i] = (const float*)d_in[i];
    a.out = (float*)d_out; a.ws = (unsigned char*)d_ws;
#if MK_ONE_LAUNCH
    a.ph_lo = 0; a.ph_hi = NPHASES;
    hipLaunchKernelGGL(mk_fwd, dim3(grid), dim3(NTHR), LDS_BYTES, stream, a);
#else
    for (int p = 0; p < NPHASES; ++p) {
        if (!phase_active(p)) continue;
        a.ph_lo = p; a.ph_hi = p + 1;
        hipLaunchKernelGGL(mk_fwd, dim3(grid), dim3(NTHR), LDS_BYTES, stream, a);
    }
#endif
}
```
